# Optimizing an MI355X kernel written in HIP

```python
import jax, jax.numpy as jnp
from jax import lax
import numpy as np

D_MODEL = 1024
BATCH = 8
SEQ = 4096
DEPTH = 4

HEAD_DIM = 64
NSA_HEADS = 8
NSA_KV_GROUPS = 2
NSA_HPG = NSA_HEADS // NSA_KV_GROUPS
CMP_LEN = 32
CMP_STRIDE = 16
CMP_HIDDEN = 256
SEL_BLOCK = 64
SEL_TOPK = 16
WINDOW = 512
NSA_QBLOCK = 64
FORCE_BONUS = 1e4
GLA_HEADS = 4
GLA_DK = 32
GLA_DV = 64
GLA_RANK = 16
GLA_TAU = 16.0
GLA_CHUNK = 64
SG_GROUPS = 4
SG_CH = 64
SG_CHUNK = 128
NSA_W = NSA_HEADS * HEAD_DIM
GLA_W = GLA_HEADS * GLA_DV
SG_W = SG_GROUPS * SG_CH
D_MIX = NSA_W + GLA_W + SG_W
KV_W = NSA_KV_GROUPS * HEAD_DIM
IN_SIZES = (NSA_W, KV_W, KV_W, KV_W, KV_W, KV_W, KV_W, NSA_HEADS * 3,
            GLA_HEADS * GLA_DK, GLA_HEADS * GLA_DK, GLA_W, GLA_RANK, GLA_W, 2 * SG_W)
D_IN = sum(IN_SIZES)
D_FF = -(-8 * D_MODEL // (3 * 256)) * 256
ROPE_THETA = 10000.0
NORM_EPS = 1e-6

kernel_name = "hybrid_nsa_gla_gmlp_trunk"


def rmsnorm(x, g):
    xf = x.astype(jnp.float32)
    y = xf * lax.rsqrt(jnp.mean(xf * xf, axis=-1, keepdims=True) + NORM_EPS)
    return (y * g.astype(jnp.float32)).astype(x.dtype)


def layernorm(x, g, b):
    xf = x.astype(jnp.float32)
    mu = jnp.mean(xf, axis=-1, keepdims=True)
    var = jnp.mean(jnp.square(xf - mu), axis=-1, keepdims=True)
    y = (xf - mu) * lax.rsqrt(var + NORM_EPS)
    return (y * g.astype(jnp.float32) + b.astype(jnp.float32)).astype(x.dtype)


def rope(x, pos):
    half = x.shape[-1] // 2
    inv = 1.0 / (ROPE_THETA ** (jnp.arange(half, dtype=jnp.float32) / half))
    ang = pos[:, None] * inv[None, :]
    cos = jnp.cos(ang)[None, :, None, :]
    sin = jnp.sin(ang)[None, :, None, :]
    xf = x.astype(jnp.float32)
    x1, x2 = xf[..., :half], xf[..., half:]
    return jnp.concatenate([x1 * cos - x2 * sin, x2 * cos + x1 * sin], axis=-1).astype(x.dtype)


def masked_softmax(s, mask):
    s = jnp.where(mask, s.astype(jnp.float32), -jnp.inf)
    m = jnp.max(s, axis=-1, keepdims=True)
    m = jnp.where(jnp.isfinite(m), m, 0.0)
    e = jnp.exp(s - m)
    d = jnp.sum(e, axis=-1, keepdims=True)
    return e / jnp.where(d > 0, d, 1.0)


def compress_blocks(k_raw, pos_emb, w1, w2):
    B, S, G, hd = k_raw.shape
    nc = (S - CMP_LEN) // CMP_STRIDE + 1
    idx = np.arange(nc)[:, None] * CMP_STRIDE + np.arange(CMP_LEN)[None, :]
    blk = k_raw[:, idx] + pos_emb[None, None, :, None, :]
    blk = blk.transpose(0, 1, 3, 2, 4).reshape(B, nc, G, CMP_LEN * hd)
    return jax.nn.gelu(blk @ w1) @ w2


def importance_map(nc, nsb):
    cs = np.arange(nc) * CMP_STRIDE
    ce = cs + CMP_LEN
    bs = np.arange(nsb) * SEL_BLOCK
    be = bs + SEL_BLOCK
    ov = np.clip(np.minimum(ce[:, None], be[None, :]) - np.maximum(cs[:, None], bs[None, :]), 0, None)
    return jnp.asarray(ov / CMP_LEN, jnp.float32)


def nsa_mixer(q, k_cmp_raw, v_cmp_raw, k_slc, v_slc, k_win, v_win, gates,
              cmp_pos_k, cmp_w1_k, cmp_w2_k, cmp_pos_v, cmp_w1_v, cmp_w2_v):
    B, S, _ = q.shape
    G, HPG, hd, QB = NSA_KV_GROUPS, NSA_HPG, HEAD_DIM, NSA_QBLOCK
    pos = jnp.arange(S, dtype=jnp.float32)
    q = rope(q.reshape(B, S, NSA_HEADS, hd), pos).reshape(B, S, G, HPG, hd) * (hd ** -0.5)
    nc = (S - CMP_LEN) // CMP_STRIDE + 1
    cmp_end_np = np.arange(nc) * CMP_STRIDE + CMP_LEN - 1
    kc = compress_blocks(k_cmp_raw.reshape(B, S, G, hd), cmp_pos_k, cmp_w1_k, cmp_w2_k)
    kc = rope(kc, jnp.asarray(cmp_end_np, jnp.float32))
    vc = compress_blocks(v_cmp_raw.reshape(B, S, G, hd), cmp_pos_v, cmp_w1_v, cmp_w2_v)
    cmp_end = jnp.asarray(cmp_end_np, jnp.int32)
    nsb = S // SEL_BLOCK
    topk = min(SEL_TOPK, nsb)
    ks = rope(k_slc.reshape(B, S, G, hd), pos)
    kb = ks.reshape(B, nsb, SEL_BLOCK, G, hd).transpose(0, 3, 1, 2, 4)
    vb = v_slc.reshape(B, nsb, SEL_BLOCK, G, hd).transpose(0, 3, 1, 2, 4)
    imp_map = importance_map(nc, nsb)
    blk_id = jnp.arange(nsb)
    bi = jnp.arange(B)[:, None, None, None]
    gi = jnp.arange(G)[None, :, None, None]
    kw = jnp.pad(rope(k_win.reshape(B, S, G, hd), pos), ((0, 0), (WINDOW, 0), (0, 0), (0, 0)))
    vw = jnp.pad(v_win.reshape(B, S, G, hd), ((0, 0), (WINDOW, 0), (0, 0), (0, 0)))
    gates = jax.nn.sigmoid(gates).reshape(B, S, G, HPG, 3)

    def query_block(i):
        s0 = i * QB
        t = s0 + jnp.arange(QB)
        qb = lax.dynamic_slice_in_dim(q, s0, QB, axis=1)
        gb = lax.dynamic_slice_in_dim(gates, s0, QB, axis=1)
        s = jnp.einsum('bqghd,bcgd->bghqc', qb, kc)
        p_cmp = masked_softmax(s, (cmp_end[None, :] <= t[:, None])[None, None, None])
        o_cmp = jnp.einsum('bghqc,bcgd->bqghd', p_cmp.astype(vc.dtype), vc)
        imp = jnp.einsum('bghqc,cn->bgqn', p_cmp, imp_map)
        tb = t // SEL_BLOCK
        valid = blk_id[None, :] * SEL_BLOCK <= t[:, None]
        forced = (blk_id[None, :] == 0) | (blk_id[None, :] == tb[:, None]) | (blk_id[None, :] == tb[:, None] - 1)
        score = jnp.where(valid, imp + jnp.where(forced, FORCE_BONUS, 0.0), -jnp.inf)
        _, idx = lax.top_k(score, topk)
        ksel = kb[bi, gi, idx].reshape(B, G, QB, topk * SEL_BLOCK, hd)
        vsel = vb[bi, gi, idx].reshape(B, G, QB, topk * SEL_BLOCK, hd)
        tok = (idx[..., None] * SEL_BLOCK + jnp.arange(SEL_BLOCK)).reshape(B, G, 1, QB, topk * SEL_BLOCK)
        s = jnp.einsum('bqghd,bgqmd->bghqm', qb, ksel)
        p = masked_softmax(s, tok <= t[None, None, None, :, None])
        o_slc = jnp.einsum('bghqm,bgqmd->bqghd', p.astype(vsel.dtype), vsel)
        kwb = lax.dynamic_slice_in_dim(kw, s0, WINDOW + QB, axis=1)
        vwb = lax.dynamic_slice_in_dim(vw, s0, WINDOW + QB, axis=1)
        kpos = s0 - WINDOW + jnp.arange(WINDOW + QB)
        wmask = (kpos[None, :] <= t[:, None]) & (kpos[None, :] > t[:, None] - WINDOW) & (kpos[None, :] >= 0)
        s = jnp.einsum('bqghd,bkgd->bghqk', qb, kwb)
        p = masked_softmax(s, wmask[None, None, None])
        o_win = jnp.einsum('bghqk,bkgd->bqghd', p.astype(vwb.dtype), vwb)
        return gb[..., 0:1] * o_cmp + gb[..., 1:2] * o_slc + gb[..., 2:3] * o_win

    out = lax.map(query_block, jnp.arange(S // QB))
    return out.transpose(1, 0, 2, 3, 4, 5).reshape(B, S, NSA_W)


def gla_mixer(q, k, v, a_lr, r, w_up, b_up, norm_g):
    B, S, _ = q.shape
    H, DK, DV, C = GLA_HEADS, GLA_DK, GLA_DV, GLA_CHUNK
    f32 = jnp.float32
    q = q.reshape(B, S, H, DK).astype(f32) * (DK ** -0.5)
    k = k.reshape(B, S, H, DK).astype(f32)
    v = v.reshape(B, S, H, DV).astype(f32)
    g = jax.nn.log_sigmoid((a_lr @ w_up + b_up).astype(f32)).reshape(B, S, H, DK) / GLA_TAU
    n = S // C

    def to_chunks(a):
        return a.reshape(B, n, C, H, a.shape[-1]).transpose(1, 0, 3, 2, 4)

    causal = jnp.tril(jnp.ones((C, C), dtype=bool))

    def step(state, inp):
        qc, kc, vc, gc = inp
        bcum = jnp.cumsum(gc, axis=2)
        o_inter = jnp.einsum('bhck,bhkv->bhcv', qc * jnp.exp(bcum), state)
        diff = bcum[:, :, :, None, :] - bcum[:, :, None, :, :]
        decay = jnp.exp(jnp.where(causal[None, None, :, :, None], diff, -jnp.inf))
        attn = jnp.einsum('bhik,bhjk,bhijk->bhij', qc, kc, decay)
        o_intra = jnp.einsum('bhij,bhjv->bhiv', attn, vc)
        blast = bcum[:, :, -1:, :]
        state = jnp.exp(blast[:, :, 0, :])[..., None] * state + jnp.einsum(
            'bhjk,bhjv->bhkv', kc * jnp.exp(blast - bcum), vc)
        return state, o_inter + o_intra

    state0 = jnp.zeros((B, H, DK, DV), f32)
    _, o = lax.scan(step, state0, (to_chunks(q), to_chunks(k), to_chunks(v), to_chunks(g)))
    o = o.transpose(1, 0, 3, 2, 4).reshape(B, S, H, DV)
    o = rmsnorm(o, norm_g) * jax.nn.silu(r.astype(f32)).reshape(B, S, H, DV)
    return o.reshape(B, S, GLA_W).astype(r.dtype)


def spatial_gating(uv, ln_g, ln_b, w_s, b_s):
    B, S, _ = uv.shape
    nch = S // SG_CHUNK
    u, v = jnp.split(jax.nn.gelu(uv), 2, axis=-1)
    v = layernorm(v, ln_g, ln_b).reshape(B, nch, SG_CHUNK, SG_GROUPS, SG_CH)
    w = jnp.tril(w_s)
    s = jnp.einsum('gij,bnjgc->bnigc', w, v) + b_s.T[None, None, :, :, None]
    out = u.reshape(B, nch, SG_CHUNK, SG_GROUPS, SG_CH) * s
    return out.reshape(B, S, SG_W)


def split_columns(z):
    offs = np.cumsum(IN_SIZES)[:-1]
    return jnp.split(z, [int(o) for o in offs], axis=-1)


def setup_inputs(seed: int = 0) -> dict:
    key = jax.random.key(seed)
    ks = jax.random.split(key, 32)
    L = DEPTH
    res = (2.0 * DEPTH) ** -0.5

    def nrm(k, shape, scale):
        return jax.random.normal(k, shape, jnp.float32) * scale

    def gain(k, shape):
        return 1.0 + nrm(k, shape, 0.02)

    return {
        "x": nrm(ks[0], (BATCH, SEQ, D_MODEL), 1.0),
        "attn_norm": gain(ks[1], (L, D_MODEL)),
        "w_in": nrm(ks[2], (L, D_MODEL, D_IN), D_MODEL ** -0.5),
        "cmp_pos_k": nrm(ks[3], (L, CMP_LEN, HEAD_DIM), 0.1),
        "cmp_w1_k": nrm(ks[4], (L, CMP_LEN * HEAD_DIM, CMP_HIDDEN), (CMP_LEN * HEAD_DIM) ** -0.5),
        "cmp_w2_k": nrm(ks[5], (L, CMP_HIDDEN, HEAD_DIM), CMP_HIDDEN ** -0.5),
        "cmp_pos_v": nrm(ks[6], (L, CMP_LEN, HEAD_DIM), 0.1),
        "cmp_w1_v": nrm(ks[7], (L, CMP_LEN * HEAD_DIM, CMP_HIDDEN), (CMP_LEN * HEAD_DIM) ** -0.5),
        "cmp_w2_v": nrm(ks[8], (L, CMP_HIDDEN, HEAD_DIM), CMP_HIDDEN ** -0.5),
        "gla_w_up": nrm(ks[9], (L, GLA_RANK, GLA_HEADS * GLA_DK), GLA_RANK ** -0.5),
        "gla_b_up": nrm(ks[10], (L, GLA_HEADS * GLA_DK), 0.1),
        "gla_norm": gain(ks[11], (L, GLA_DV)),
        "sg_ln_g": gain(ks[12], (L, SG_W)),
        "sg_ln_b": nrm(ks[13], (L, SG_W), 0.02),
        "sg_w": nrm(ks[14], (L, SG_GROUPS, SG_CHUNK, SG_CHUNK), SG_CHUNK ** -0.5),
        "sg_b": 1.0 + nrm(ks[15], (L, SG_GROUPS, SG_CHUNK), 0.1),
        "w_out": nrm(ks[16], (L, D_MIX, D_MODEL), D_MIX ** -0.5 * res),
        "ffn_norm": gain(ks[17], (L, D_MODEL)),
        "w_gate": nrm(ks[18], (L, D_MODEL, D_FF), D_MODEL ** -0.5),
        "w_up": nrm(ks[19], (L, D_MODEL, D_FF), D_MODEL ** -0.5),
        "w_down": nrm(ks[20], (L, D_FF, D_MODEL), D_FF ** -0.5 * res),
        "final_norm": gain(ks[21], (D_MODEL,)),
    }


def reference(x, attn_norm, w_in, cmp_pos_k, cmp_w1_k, cmp_w2_k, cmp_pos_v, cmp_w1_v, cmp_w2_v,
              gla_w_up, gla_b_up, gla_norm, sg_ln_g, sg_ln_b, sg_w, sg_b, w_out,
              ffn_norm, w_gate, w_up, w_down, final_norm):
    for l in range(DEPTH):
        h = rmsnorm(x, attn_norm[l])
        (q, kc, vc, ksl, vsl, kwn, vwn, gts, gq, gk, gv, ga, gr, uv) = split_columns(h @ w_in[l])
        o_nsa = nsa_mixer(q, kc, vc, ksl, vsl, kwn, vwn, gts,
                          cmp_pos_k[l], cmp_w1_k[l], cmp_w2_k[l], cmp_pos_v[l], cmp_w1_v[l], cmp_w2_v[l])
        o_gla = gla_mixer(gq, gk, gv, ga, gr, gla_w_up[l], gla_b_up[l], gla_norm[l])
        o_sg = spatial_gating(uv, sg_ln_g[l], sg_ln_b[l], sg_w[l], sg_b[l])
        x = x + jnp.concatenate([o_nsa, o_gla.astype(x.dtype), o_sg], axis=-1) @ w_out[l]
        h = rmsnorm(x, ffn_norm[l])
        x = x + (jax.nn.silu(h @ w_gate[l]) * (h @ w_up[l])) @ w_down[l]
    return rmsnorm(x, final_norm)
```

```cpp
#include <hip/hip_runtime.h>
#include <hip/hip_cooperative_groups.h>
#include <cstdio>
#include <cstdint>
#include <cmath>
namespace cg = cooperative_groups;

#define LAS __attribute__((address_space(3)))
typedef unsigned short bf16_t;
typedef short bf16x8 __attribute__((ext_vector_type(8)));
typedef short s16x4 __attribute__((ext_vector_type(4)));
typedef float f32x4 __attribute__((ext_vector_type(4)));
typedef float f32x2 __attribute__((ext_vector_type(2)));
typedef float f32x16 __attribute__((ext_vector_type(16)));
typedef unsigned u32x4 __attribute__((ext_vector_type(4)));
typedef unsigned u32x2 __attribute__((ext_vector_type(2)));
typedef __bf16 bf16x2_t __attribute__((ext_vector_type(2)));
#define DI __device__ __forceinline__

constexpr int BATCH = 8, SEQ = 4096, DM = 1024, NL = 4, MTOK = BATCH * SEQ;
constexpr int NZ = 2816, DFF = 2816, DIN = 2600;
constexpr int ZQ = 0, ZKC = 512, ZVC = 640, ZKS = 768, ZVS = 896, ZKW = 1024, ZVW = 1152, ZGQ = 1280, ZGK = 1408, ZGV = 1536, ZGR = 1792, ZUV = 2048, ZGT = 2560, ZGA = 2592;
constexpr float EPS = 1e-6f;
constexpr float QSCALE = 0.125f * 1.4426950408889634f;

constexpr size_t al256(size_t x) { return (x + 255) & ~(size_t)255; }
constexpr int WP = DM + 64, WPC = 2048 + 64;
constexpr size_t WS_WIN = 0;
constexpr size_t WS_WOUT = WS_WIN + al256((size_t)NL * NZ * WP * 2);
constexpr size_t WS_WGU = WS_WOUT + al256((size_t)NL * DM * WP * 2);
constexpr size_t WS_WDN = WS_WGU + al256((size_t)NL * 2 * DFF * WP * 2);
constexpr size_t WS_WC1 = WS_WDN + al256((size_t)NL * DM * DFF * 2);
constexpr size_t WS_SGW = WS_WC1 + al256((size_t)NL * 2 * 256 * WPC * 2);
constexpr size_t WS_ROPE = WS_SGW + al256((size_t)NL * 4 * 128 * 128 * 2);
constexpr size_t WS_POSB = WS_ROPE + al256((size_t)4096 * 64 * 4);
constexpr size_t WS_XB = WS_POSB + al256((size_t)NL * 2 * 256 * 4);
constexpr size_t WS_SSQA = WS_XB + al256((size_t)MTOK * DM * 2);
constexpr size_t WS_SSQB = WS_SSQA + al256((size_t)MTOK * 16 * 4);
constexpr size_t WS_Z = WS_SSQB + al256((size_t)MTOK * 16 * 4);
constexpr size_t WS_MIX = WS_Z + al256((size_t)(MTOK + 64) * NZ * 2);
constexpr size_t WS_CH = WS_MIX + al256((size_t)MTOK * DM * 2);
constexpr size_t WS_KC = WS_CH + al256((size_t)4 * 2048 * 256 * 2);
constexpr size_t WS_VC = WS_KC + al256((size_t)16 * 256 * 64 * 2);
constexpr size_t WS_GDS = WS_VC + al256((size_t)16 * 256 * 64 * 2);
constexpr size_t WS_GDEC = WS_GDS + al256((size_t)2048 * 2048 * 4);
constexpr size_t WS_W2T = WS_GDEC + al256((size_t)2048 * 32 * 4);
constexpr size_t WS_XL = WS_W2T + al256((size_t)NL * 2 * 64 * 256 * 2);
constexpr size_t WS_CTL = WS_XL + al256((size_t)MTOK * DM * 2);
constexpr size_t WS_END = WS_CTL + 65536;

constexpr int LDS_MISC = 139264;
constexpr int LDS_BYTES = LDS_MISC + 4096;

DI unsigned f2bf(float f) { unsigned u = __builtin_bit_cast(unsigned, f); return (u + 0x7fffu + ((u >> 16) & 1u)) >> 16; }
DI float bf2f(unsigned short h) { return __builtin_bit_cast(float, (unsigned)h << 16); }
DI unsigned pk2(float lo, float hi) { f32x2 v = {lo, hi}; bf16x2_t b = __builtin_convertvector(v, bf16x2_t); return __builtin_bit_cast(unsigned, b); }
DI float bflo(unsigned w) { return __builtin_bit_cast(float, w << 16); }
DI float bfhi(unsigned w) { return __builtin_bit_cast(float, w & 0xffff0000u); }
DI float wave_sum(float v) {
#pragma unroll
    for (int o = 1; o < 64; o <<= 1) v += __shfl_xor(v, o);
    return v;
}
DI float gelu_tanh(float x) { const float u = x * __builtin_fmaf(x * x, -0.10294324f, -2.3022082f); return x * __builtin_amdgcn_rcpf(1.0f + __builtin_amdgcn_exp2f(u)); }
DI float sigmoidf_(float x) { return __builtin_amdgcn_rcpf(1.0f + __builtin_amdgcn_exp2f(-1.4426950408889634f * x)); }
DI float siluf_(float x) { return x * __builtin_amdgcn_rcpf(1.0f + __builtin_amdgcn_exp2f(-1.4426950408889634f * x)); }
DI int otid() { int t = threadIdx.x; asm volatile("" : "+v"(t)); return t; }
DI int crow(int r, int hi) { return (r & 3) + 8 * (r >> 2) + 4 * hi; }
#define MFMA32(a, b, c) __builtin_amdgcn_mfma_f32_32x32x16_bf16((a), (b), (c), 0, 0, 0)

struct Params {
    const float* in[22];
    float* out;
    unsigned char* ws;
};

namespace pg8 {
constexpr int BM = 256, BK = 64, HALF = 128, HTB = HALF * BK * 2, STAGE_BYTES = 8 * HTB, NXCD = 8, WGM = 2;
__host__ __device__ __forceinline__ int lds_byte(int r, int c) { const int st = (r >> 4) * 2 + (c >> 5), rr = r & 15, cc = c & 31, ob = rr * 64 + cc * 2; return st * 1024 + (ob ^ (((ob >> 9) & 1) << 5)); }
__host__ __device__ __forceinline__ void stage_rc(int b, int& R, int& C) { const int st = b / 1024, sb = b % 1024, swz = sb ^ (((sb >> 9) & 1) << 5); R = (st >> 1) * 16 + swz / 64; C = (st & 1) * 32 + (swz % 64) / 2; }
__host__ __device__ __forceinline__ int perm32(int rho) { const int n = rho >> 4, i = rho & 15; return 8 * (i >> 2) + 4 * n + (i & 3); }
struct Unit { int pm, pn; };
struct Gemm { const bf16_t* A; const bf16_t* Bt; int K; unsigned lda_b; unsigned kstepA_b; unsigned ldb_b; };
struct StaticOrder {
    int nM, nN, nwg, G, c;
    __device__ void init(int M, int N, int G_, int c_) { nM = M / BM; nN = N / BM; nwg = nM * nN; G = G_; c = c_; }
    __device__ bool next(int i, Unit& u) const {
        const long L = (long)i * G + c; if (L >= nwg) return false;
        int wgid = (int)L; { const int q = nwg / NXCD, r = nwg % NXCD, xcd = wgid % NXCD, off = wgid / NXCD; wgid = (xcd < r ? xcd * (q + 1) : r * (q + 1) + (xcd - r) * q) + off; }
        const int nig = WGM * nN, gid = wgid / nig, fm = gid * WGM, gsz = (nM - fm) < WGM ? (nM - fm) : WGM;
        u.pm = fm + ((wgid % nig) % gsz); u.pn = (wgid % nig) / gsz; return true;
    }
};
struct OneUnit { int pm; __device__ bool next(int i, Unit& u) const { if (i) return false; u.pm = pm; u.pn = 0; return true; } };

template <class Epi, class Sched>
DI void gemm_phase(LAS unsigned char* lds, const Gemm g, const Sched& S, const Epi& E) {
    const int tid = otid(), wid = __builtin_amdgcn_readfirstlane(tid >> 6), lane = tid & 63, wr = wid >> 2, wc = wid & 3, fr = lane & 15, fq = lane >> 4;
    const int K = g.K, nt = K / BK; const unsigned ldb = g.ldb_b ? g.ldb_b : (unsigned)K * 2u;
    unsigned voffA[2], voffB[2];
#pragma unroll
    for (int i = 0; i < 2; ++i) { int R, C; stage_rc(tid * 16 + i * 8192, R, C); const int Rb = (R & ~31) + perm32(R & 31);
        voffA[i] = (unsigned)R * g.lda_b + (unsigned)C * 2u; voffB[i] = (unsigned)Rb * ldb + (unsigned)C * 2u; }
    const size_t kstepA = g.kstepA_b, kstepB = (size_t)(BK * 2);
    const size_t hstepA = (size_t)HALF * g.lda_b, hstepB = (size_t)HALF * ldb;
    const size_t tstepA = 2 * hstepA, tstepB = 2 * hstepB;
    const unsigned ldsw = (unsigned)wid * 1024u;
    const int aoff = lds_byte(wr * 64 + fr, fq * 8), boff = lds_byte(wc * 32 + fr, fq * 8);
#define PG8_SA(b, h) (((b) * 2 + (h)) * HTB)
#define PG8_SB(b, h) ((4 + (b) * 2 + (h)) * HTB)
#define PG8_STAGE(bufoff, gbase, voff) do { _Pragma("unroll") for (int _i = 0; _i < 2; ++_i) \
        __builtin_amdgcn_global_load_lds((const unsigned*)((const char*)(gbase) + (voff)[_i]), (LAS unsigned*)(lds + (bufoff) + ldsw + _i * 8192), 16, 0, 0); } while (0)
#define PG8_LDA(dst, b, h) do { _Pragma("unroll") for (int m = 0; m < 4; ++m) _Pragma("unroll") for (int k = 0; k < 2; ++k) dst[m][k] = *(const LAS bf16x8*)(lds + PG8_SA(b, h) + aoff + m * 2048 + k * 1024); } while (0)
#define PG8_LDB(dst, b, h) do { _Pragma("unroll") for (int n = 0; n < 2; ++n) _Pragma("unroll") for (int k = 0; k < 2; ++k) dst[n][k] = *(const LAS bf16x8*)(lds + PG8_SB(b, h) + boff + n * 2048 + k * 1024); } while (0)
#define PG8_MMA(ai, bj, At, Bt) do { __builtin_amdgcn_s_setprio(1); _Pragma("unroll") for (int m = 0; m < 4; ++m) _Pragma("unroll") for (int n = 0; n < 2; ++n) _Pragma("unroll") for (int k = 0; k < 2; ++k) \
        acc[ai][bj][m][n] = __builtin_amdgcn_mfma_f32_16x16x32_bf16(Bt[n][k], At[m][k], acc[ai][bj][m][n], 0, 0, 0); __builtin_amdgcn_s_setprio(0); } while (0)
#define PG8_WAIT_V(n) asm volatile("s_waitcnt vmcnt(" #n ")" ::: "memory")
#define PG8_WAIT_L(n) asm volatile("s_waitcnt lgkmcnt(" #n ")" ::: "memory")
#define PG8_BAR __builtin_amdgcn_s_barrier()
#define PG8_SCHED __builtin_amdgcn_sched_barrier(0)
    Unit cur, nxt; int ui = 0;
    if (!S.next(0, cur)) return;
    f32x4 acc[2][2][4][2];
#pragma unroll
    for (int a = 0; a < 2; ++a)
#pragma unroll
        for (int b = 0; b < 2; ++b)
#pragma unroll
            for (int m = 0; m < 4; ++m)
#pragma unroll
                for (int n = 0; n < 2; ++n) acc[a][b][m][n] = (f32x4){0.f, 0.f, 0.f, 0.f};
    bf16x8 At[4][2], B0[2][2], B1[2][2];
    const char* cA = (const char*)g.A + (size_t)cur.pm * tstepA; const char* cB = (const char*)g.Bt + (size_t)cur.pn * tstepB;
    PG8_STAGE(PG8_SB(0, 0), cB, voffB); PG8_STAGE(PG8_SB(0, 1), cB + hstepB, voffB); PG8_STAGE(PG8_SA(0, 0), cA, voffA); PG8_STAGE(PG8_SA(0, 1), cA + hstepA, voffA);
    if (wr == 1) PG8_BAR;
    PG8_WAIT_V(2); PG8_BAR;
    PG8_STAGE(PG8_SB(1, 0), cB + kstepB, voffB); PG8_STAGE(PG8_SA(1, 0), cA + kstepA, voffA); PG8_STAGE(PG8_SB(1, 1), cB + hstepB + kstepB, voffB);
    PG8_WAIT_V(6); PG8_BAR;
    for (;;) {
        const bool has_next = S.next(ui + 1, nxt);
        const char* nA = has_next ? (const char*)g.A + (size_t)nxt.pm * tstepA : cA; const char* nB = has_next ? (const char*)g.Bt + (size_t)nxt.pn * tstepB : cB;
        for (int t = 0; t < nt; t += 2) {
            const bool last = (t == nt - 2);
            const char* a1 = cA + (size_t)(t + 1) * kstepA;
            const char* a2 = last ? nA : cA + (size_t)(t + 2) * kstepA; const char* b2 = last ? nB : cB + (size_t)(t + 2) * kstepB;
            const char* a3 = a2 + kstepA; const char* b3 = b2 + kstepB;
            PG8_LDB(B0, 0, 0); PG8_LDB(B1, 0, 1); PG8_SCHED; PG8_LDA(At, 0, 0); PG8_STAGE(PG8_SA(1, 1), a1 + hstepA, voffA);
            PG8_WAIT_V(8); PG8_WAIT_L(0); PG8_BAR; PG8_MMA(0, 0, At, B0); PG8_MMA(0, 1, At, B1); PG8_BAR; PG8_SCHED;
            PG8_LDA(At, 0, 1); PG8_STAGE(PG8_SB(0, 0), b2, voffB); PG8_STAGE(PG8_SB(0, 1), b2 + hstepB, voffB); PG8_STAGE(PG8_SA(0, 0), a2, voffA);
            PG8_WAIT_V(8); PG8_WAIT_L(0); PG8_BAR; PG8_MMA(1, 0, At, B0); PG8_MMA(1, 1, At, B1); PG8_BAR; PG8_SCHED;
            PG8_LDB(B0, 1, 0); PG8_LDB(B1, 1, 1); PG8_SCHED; PG8_LDA(At, 1, 0); PG8_STAGE(PG8_SA(0, 1), a2 + hstepA, voffA);
            PG8_WAIT_V(8); PG8_WAIT_L(0); PG8_BAR; PG8_MMA(0, 0, At, B0); PG8_MMA(0, 1, At, B1); PG8_BAR; PG8_SCHED;
            PG8_LDA(At, 1, 1); PG8_STAGE(PG8_SB(1, 0), b3, voffB); PG8_STAGE(PG8_SB(1, 1), b3 + hstepB, voffB); PG8_STAGE(PG8_SA(1, 0), a3, voffA);
            PG8_WAIT_V(8); PG8_WAIT_L(0); PG8_BAR; PG8_MMA(1, 0, At, B0); PG8_MMA(1, 1, At, B1); PG8_BAR; PG8_SCHED;
        }
        if (wr == 0) PG8_BAR;
        E(acc, cur, wr, wc, fr, fq);
        if (!has_next) break;
#pragma unroll
        for (int a = 0; a < 2; ++a)
#pragma unroll
            for (int b = 0; b < 2; ++b)
#pragma unroll
                for (int m = 0; m < 4; ++m)
#pragma unroll
                    for (int n = 0; n < 2; ++n) acc[a][b][m][n] = (f32x4){0.f, 0.f, 0.f, 0.f};
        cur = nxt; cA = nA; cB = nB; ++ui;
        if (wr == 1) PG8_BAR;
    }
    PG8_WAIT_V(0);
    PG8_BAR;
#undef PG8_SA
#undef PG8_SB
#undef PG8_STAGE
#undef PG8_LDA
#undef PG8_LDB
#undef PG8_MMA
#undef PG8_WAIT_V
#undef PG8_WAIT_L
#undef PG8_BAR
#undef PG8_SCHED
}
}
using pg8::Unit;

DI float row_rinv(const float* ssq, int row, int fq) {
    const f32x4 sv = *(const f32x4*)(ssq + (size_t)row * 16 + 4 * fq);
    float s = (sv.x + sv.y) + (sv.z + sv.w); s += __shfl_xor(s, 16); s += __shfl_xor(s, 32);
    return rsqrtf(s * (1.0f / DM) + EPS);
}
DI void rows_rinv(const float* ssq, int row0, int fq, float (&rinv)[2][4]) {
    f32x4 sv[2][4];
#pragma unroll
    for (int ai = 0; ai < 2; ++ai)
#pragma unroll
        for (int m = 0; m < 4; ++m) sv[ai][m] = *(const f32x4*)(ssq + (size_t)(row0 + ai * 128 + m * 16) * 16 + 4 * fq);
#pragma unroll
    for (int ai = 0; ai < 2; ++ai)
#pragma unroll
        for (int m = 0; m < 4; ++m) { float t = (sv[ai][m].x + sv[ai][m].y) + (sv[ai][m].z + sv[ai][m].w); t += __shfl_xor(t, 16); t += __shfl_xor(t, 32); rinv[ai][m] = rsqrtf(t * (1.0f / DM) + EPS); }
}
struct EpiIn {
    bf16_t* Z; const float* ssq; const float* rope;
    DI void operator()(const f32x4 (&acc)[2][2][4][2], const Unit& u, int wr, int wc, int fr, int fq) const {
        const int pn = u.pn;
        int mode = 0; float scale = 1.f;
        if (pn < 2) { mode = 1; scale = QSCALE; }
        else if (pn == 3 || pn == 4) mode = (wc < 2) ? 1 : 0;
        else if (pn == 5) scale = (wc < 2) ? 0.17677669529663687f : 1.f;
        else if (pn == 8 || pn == 9) mode = 3;
        else if (pn == 10) mode = 4;
        const int lcol = pn * 256 + wc * 64 + 8 * fq;
        float rinvs[2][4]; rows_rinv(ssq, u.pm * 256 + wr * 64 + fr, fq, rinvs);
#pragma unroll
        for (int ai = 0; ai < 2; ++ai)
#pragma unroll
            for (int m = 0; m < 4; ++m) {
                const int row = u.pm * 256 + ai * 128 + wr * 64 + m * 16 + fr;
                const float rinv = rinvs[ai][m];
                f32x4 v00 = acc[ai][0][m][0] * rinv, v01 = acc[ai][0][m][1] * rinv, v10 = acc[ai][1][m][0] * rinv, v11 = acc[ai][1][m][1] * rinv;
                if (mode == 1) {
                    const float* rp = rope + (size_t)(row & (SEQ - 1)) * 64 + 8 * fq;
                    const f32x4 c0 = *(const f32x4*)rp, c1 = *(const f32x4*)(rp + 4), s0 = *(const f32x4*)(rp + 32), s1 = *(const f32x4*)(rp + 36);
                    const f32x4 a0 = v00 * c0 - v10 * s0, b0 = v10 * c0 + v00 * s0, a1 = v01 * c1 - v11 * s1, b1 = v11 * c1 + v01 * s1;
                    v00 = a0 * scale; v10 = b0 * scale; v01 = a1 * scale; v11 = b1 * scale;
                } else if (mode == 3) {
#pragma unroll
                    for (int e = 0; e < 4; ++e) { v00[e] = gelu_tanh(v00[e]); v01[e] = gelu_tanh(v01[e]); v10[e] = gelu_tanh(v10[e]); v11[e] = gelu_tanh(v11[e]); }
                } else if (mode == 4) {
                    if (wc == 0 && fq < 3) {
#pragma unroll
                        for (int e = 0; e < 4; ++e) { v00[e] = sigmoidf_(v00[e]); v01[e] = sigmoidf_(v01[e]); }
                    }
                } else { v00 = v00 * scale; v01 = v01 * scale; v10 = v10 * scale; v11 = v11 * scale; }
                bf16_t* zp = Z + (size_t)row * NZ + lcol;
                u32x4 w0, w1;
                w0.x = pk2(v00[0], v00[1]); w0.y = pk2(v00[2], v00[3]); w0.z = pk2(v01[0], v01[1]); w0.w = pk2(v01[2], v01[3]);
                w1.x = pk2(v10[0], v10[1]); w1.y = pk2(v10[2], v10[3]); w1.z = pk2(v11[0], v11[1]); w1.w = pk2(v11[2], v11[3]);
                *(u32x4*)zp = w0; *(u32x4*)(zp + 32) = w1;
            }
    }
};
struct EpiRes {
    bf16_t* XH; bf16_t* XL; float* ssq_out;
    DI void operator()(const f32x4 (&acc)[2][2][4][2], const Unit& u, int wr, int wc, int fr, int fq) const {
        const int col0 = u.pn * 256 + wc * 32 + 8 * fq;
#pragma unroll
        for (int ai = 0; ai < 2; ++ai) {
            u32x4 hv[4][2], lv[4][2];
#pragma unroll
            for (int m = 0; m < 4; ++m) { const size_t off = (size_t)(u.pm * 256 + ai * 128 + wr * 64 + m * 16 + fr) * DM + col0;
#pragma unroll
                for (int bj = 0; bj < 2; ++bj) { hv[m][bj] = *(const u32x4*)(XH + off + bj * 128); lv[m][bj] = *(const u32x4*)(XL + off + bj * 128); } }
#pragma unroll
            for (int m = 0; m < 4; ++m) {
                const int row = u.pm * 256 + ai * 128 + wr * 64 + m * 16 + fr; const size_t off = (size_t)row * DM + col0;
                float sq = 0.f;
#pragma unroll
                for (int bj = 0; bj < 2; ++bj) {
                    float x[8];
#pragma unroll
                    for (int e = 0; e < 4; ++e) { x[2 * e] = (bflo(hv[m][bj][e]) + bflo(lv[m][bj][e])) + acc[ai][bj][m][e >> 1][(2 * e) & 3]; x[2 * e + 1] = (bfhi(hv[m][bj][e]) + bfhi(lv[m][bj][e])) + acc[ai][bj][m][e >> 1][(2 * e + 1) & 3]; }
                    u32x4 wh, wl;
#pragma unroll
                    for (int e = 0; e < 4; ++e) { wh[e] = pk2(x[2 * e], x[2 * e + 1]); wl[e] = pk2(x[2 * e] - bflo(wh[e]), x[2 * e + 1] - bfhi(wh[e])); sq += x[2 * e] * x[2 * e] + x[2 * e + 1] * x[2 * e + 1]; }
                    *(u32x4*)(XH + off + bj * 128) = wh; *(u32x4*)(XL + off + bj * 128) = wl;
                }
                sq += __shfl_xor(sq, 16); sq += __shfl_xor(sq, 32);
                if (fq == 0) ssq_out[(size_t)row * 16 + u.pn * 4 + wc] = sq;
            }
        }
    }
};
struct EpiGlu {
    bf16_t* H; const float* ssq;
    DI void operator()(const f32x4 (&acc)[2][2][4][2], const Unit& u, int wr, int wc, int fr, int fq) const {
        const int col0 = u.pn * 128 + wc * 32 + 8 * fq;
        float rinvs[2][4]; rows_rinv(ssq, u.pm * 256 + wr * 64 + fr, fq, rinvs);
#pragma unroll
        for (int ai = 0; ai < 2; ++ai)
#pragma unroll
            for (int m = 0; m < 4; ++m) {
                const int row = u.pm * 256 + ai * 128 + wr * 64 + m * 16 + fr;
                const float rinv = rinvs[ai][m];
                float o[8];
#pragma unroll
                for (int n = 0; n < 2; ++n)
#pragma unroll
                    for (int e = 0; e < 4; ++e) { const float gt = acc[ai][0][m][n][e] * rinv, up = acc[ai][1][m][n][e] * rinv; o[n * 4 + e] = siluf_(gt) * up; }
                u32x4 w; w.x = pk2(o[0], o[1]); w.y = pk2(o[2], o[3]); w.z = pk2(o[4], o[5]); w.w = pk2(o[6], o[7]);
                *(u32x4*)(H + (size_t)row * DFF + col0) = w;
            }
    }
};
struct EpiCmp {
    bf16_t* CH; const float* bias;
    DI void operator()(const f32x4 (&acc)[2][2][4][2], const Unit& u, int wr, int wc, int fr, int fq) const {
        const int col0 = wc * 32 + 8 * fq;
#pragma unroll
        for (int ai = 0; ai < 2; ++ai)
#pragma unroll
            for (int m = 0; m < 4; ++m) {
                const int row = u.pm * 256 + ai * 128 + wr * 64 + m * 16 + fr;
#pragma unroll
                for (int bj = 0; bj < 2; ++bj) {
                    const f32x4 b0 = *(const f32x4*)(bias + col0 + bj * 128), b1 = *(const f32x4*)(bias + col0 + bj * 128 + 4);
                    const f32x4 v0 = acc[ai][bj][m][0] + b0, v1 = acc[ai][bj][m][1] + b1;
                    u32x4 w; w.x = pk2(gelu_tanh(v0[0]), gelu_tanh(v0[1])); w.y = pk2(gelu_tanh(v0[2]), gelu_tanh(v0[3])); w.z = pk2(gelu_tanh(v1[0]), gelu_tanh(v1[1])); w.w = pk2(gelu_tanh(v1[2]), gelu_tanh(v1[3]));
                    *(u32x4*)(CH + (size_t)row * 256 + col0 + bj * 128) = w;
                }
            }
    }
};

DI int srccol(int zc) {
    if (zc < 1280) return zc;
    if (zc < 1792) return zc + 24;
    if (zc < 2560) return zc + 40;
    if (zc < 2584) return 1280 + (zc - 2560);
    if (zc >= 2592 && zc < 2608) return 1816 + (zc - 2592);
    return -1;
}
struct FIn { const float* w; const float* g; DI float operator()(int k, int n) const {
    const int tile = n >> 8, loc = n & 255, bj = loc >> 7, wc = (loc >> 5) & 3, x = loc & 31; const int sc = srccol(tile * 256 + wc * 64 + bj * 32 + x);
    return sc < 0 ? 0.f : w[(size_t)k * DIN + sc] * g[k]; } };
struct FPlain { const float* w; int ldw; DI float operator()(int k, int n) const { return w[(size_t)k * ldw + n]; } };
struct FGu { const float* wg; const float* wu; const float* g; DI float operator()(int k, int n) const {
    const int tile = n >> 8, loc = n & 255, bj = loc >> 7, col = tile * 128 + (loc & 127); const float* base = (const float*)((uintptr_t)wg + (bj ? (uintptr_t)wu - (uintptr_t)wg : (uintptr_t)0)); return base[(size_t)k * DFF + col] * g[k]; } };
template <class F> DI void tr_item(const F& f, int pitch, bf16_t* WT, float* scr, int kb, int nb, int lane) {
    const int k0 = 64 * kb, n0 = 32 * nb;
#pragma unroll 8
    for (int i = 0; i < 32; ++i) { const int kk = 2 * i + (lane >> 5); scr[kk * 33 + (lane & 31)] = f(k0 + kk, n0 + (lane & 31)); }
    __builtin_amdgcn_s_waitcnt(0xc07f); asm volatile("" ::: "memory");
    const int c = lane & 7;
#pragma unroll
    for (int j = 0; j < 4; ++j) { const int n = (lane >> 3) + 8 * j; const float* s = scr + (8 * c) * 33 + n;
        u32x4 o; o.x = pk2(s[0 * 33], s[1 * 33]); o.y = pk2(s[2 * 33], s[3 * 33]); o.z = pk2(s[4 * 33], s[5 * 33]); o.w = pk2(s[6 * 33], s[7 * 33]);
        *(u32x4*)(WT + (size_t)(n0 + n) * pitch + k0 + 8 * c) = o; }
    __builtin_amdgcn_s_waitcnt(0xc07f); asm volatile("" ::: "memory");
}
DI void phase0(const Params& p, unsigned char* lds) {
    const int tid = otid(), lane = tid & 63, wave = tid >> 6;
    const int gw = blockIdx.x * 8 + wave, NGW = gridDim.x * 8;
    float* scr = (float*)lds + wave * (64 * 33);
    unsigned char* ws = p.ws;
    constexpr int I_IN = 16 * 88, I_OUT = 16 * 32, I_GU = 16 * 176, I_DN = 44 * 32, I_C = 32 * 8, I_L = I_IN + I_OUT + I_GU + I_DN + 2 * I_C;
    for (int it = gw; it < NL * I_L; it += NGW) {
        const int l = it / I_L; int r = it % I_L;
        if (r < I_IN) { FIn f{p.in[2] + (size_t)l * DM * DIN, p.in[1] + l * DM}; tr_item(f, WP, (bf16_t*)(ws + WS_WIN) + (size_t)l * NZ * WP, scr, r / 88, r % 88, lane); continue; } r -= I_IN;
        if (r < I_OUT) { FPlain f{p.in[16] + (size_t)l * DM * DM, DM}; tr_item(f, WP, (bf16_t*)(ws + WS_WOUT) + (size_t)l * DM * WP, scr, r / 32, r % 32, lane); continue; } r -= I_OUT;
        if (r < I_GU) { FGu f{p.in[18] + (size_t)l * DM * DFF, p.in[19] + (size_t)l * DM * DFF, p.in[17] + l * DM}; tr_item(f, WP, (bf16_t*)(ws + WS_WGU) + (size_t)l * 2 * DFF * WP, scr, r / 176, r % 176, lane); continue; } r -= I_GU;
        if (r < I_DN) { FPlain f{p.in[20] + (size_t)l * DFF * DM, DM}; tr_item(f, DFF, (bf16_t*)(ws + WS_WDN) + (size_t)l * DM * DFF, scr, r / 32, r % 32, lane); continue; } r -= I_DN;
        const int kv = r / I_C; r %= I_C;
        FPlain f{(kv ? p.in[7] : p.in[4]) + (size_t)l * 2048 * 256, 256}; tr_item(f, WPC, (bf16_t*)(ws + WS_WC1) + (size_t)(l * 2 + kv) * 256 * WPC, scr, r / 8, r % 8, lane);
    }
    {
        const float* x = p.in[0]; bf16_t* XH = (bf16_t*)(ws + WS_XB); bf16_t* XLo = (bf16_t*)(ws + WS_XL); float* ssq = (float*)(ws + WS_SSQA);
        for (int m = gw; m < MTOK; m += NGW) {
            const f32x4* xr = (const f32x4*)(x + (size_t)m * DM) + lane; u32x2* ho = (u32x2*)(XH + (size_t)m * DM) + lane; u32x2* lo = (u32x2*)(XLo + (size_t)m * DM) + lane;
            float s = 0.f;
#pragma unroll
            for (int j = 0; j < 4; ++j) { const f32x4 v = xr[64 * j]; u32x2 wh, wl; wh.x = pk2(v.x, v.y); wh.y = pk2(v.z, v.w);
                wl.x = pk2(v.x - bflo(wh.x), v.y - bfhi(wh.x)); wl.y = pk2(v.z - bflo(wh.y), v.w - bfhi(wh.y)); ho[64 * j] = wh; lo[64 * j] = wl; s += (v.x * v.x + v.y * v.y) + (v.z * v.z + v.w * v.w); }
            s = wave_sum(s);
            if (lane < 16) ssq[(size_t)m * 16 + lane] = lane == 0 ? s : 0.f;
        }
    }
    const int gt = blockIdx.x * 512 + tid, NGT = gridDim.x * 512;
    { float* rope = (float*)(ws + WS_ROPE);
      for (int i = gt; i < SEQ * 32; i += NGT) { const int pos = i >> 5, j = i & 31; const float inv = __builtin_amdgcn_exp2f(-(float)j * (13.287712379549449f / 32.0f)); const float ang = (float)pos * inv; double rev = (double)ang * 0.15915494309189535; rev -= __builtin_floor(rev); const float rf = (float)rev; const float sn = __builtin_amdgcn_sinf(rf), cs = __builtin_amdgcn_cosf(rf); rope[pos * 64 + j] = cs; rope[pos * 64 + 32 + j] = sn; } }
    { float* posb = (float*)(ws + WS_POSB); float* red = (float*)lds + 8 * 64 * 33;
      for (int job = blockIdx.x; job < NL * 2 * 8; job += gridDim.x) { const int nc = job & 7, kv = (job >> 3) & 1, l = job >> 4, nl = tid & 31, ks = tid >> 5;
          const float* pe = (kv ? p.in[6] : p.in[3]) + (size_t)l * 2048 + ks * 128; const float* w1 = (kv ? p.in[7] : p.in[4]) + (size_t)l * 2048 * 256 + (size_t)ks * 128 * 256 + nc * 32 + nl;
          float s0 = 0.f, s1 = 0.f, s2 = 0.f, s3 = 0.f;
#pragma unroll 4
          for (int k = 0; k < 128; k += 4) { s0 += pe[k] * w1[(size_t)k * 256]; s1 += pe[k + 1] * w1[(size_t)(k + 1) * 256]; s2 += pe[k + 2] * w1[(size_t)(k + 2) * 256]; s3 += pe[k + 3] * w1[(size_t)(k + 3) * 256]; }
          red[ks * 32 + nl] = (s0 + s1) + (s2 + s3);
          __syncthreads();
          if (tid < 32) { float t = 0.f; for (int q = 0; q < 16; ++q) t += red[q * 32 + tid]; posb[(l * 2 + kv) * 256 + nc * 32 + tid] = t; }
          __syncthreads(); } }
    { bf16_t* w2t = (bf16_t*)(ws + WS_W2T);
      for (int i = gt; i < NL * 2 * 64 * 256; i += NGT) { const int k = i & 255, d = (i >> 8) & 63, kv = (i >> 14) & 1, l = i >> 15; w2t[i] = (bf16_t)f2bf((kv ? p.in[8] : p.in[5])[(size_t)l * 256 * 64 + k * 64 + d]); } }
    { bf16_t* sgw = (bf16_t*)(ws + WS_SGW); const float* w = p.in[14];
      for (int i = gt; i < NL * 4 * 128 * 128; i += NGT) { const int j = i & 127, ii = (i >> 7) & 127; sgw[i] = (bf16_t)f2bf(j <= ii ? w[i] : 0.f); } }
}

DI void compress2(const Params& p, int l, int set, int pm) {
    const int tid = otid(), lane = tid & 63, w = tid >> 6, r32 = lane & 31, hi = lane >> 5;
    const int kv = set >> 1, g = set & 1, rbase = pm * 256 + w * 32;
    const bf16_t* A = (const bf16_t*)(p.ws + WS_CH) + ((size_t)set * 2048 + rbase + r32) * 256 + 8 * hi;
    const bf16_t* Bt = (const bf16_t*)(p.ws + WS_W2T) + (size_t)(l * 2 + kv) * 64 * 256 + (size_t)r32 * 256 + 8 * hi;
    f32x16 a0 = {}, a1 = {};
#pragma unroll 4
    for (int k0 = 0; k0 < 256; k0 += 16) { const bf16x8 av = *(const bf16x8*)(A + k0), b0 = *(const bf16x8*)(Bt + k0), b1 = *(const bf16x8*)(Bt + 32 * 256 + k0); a0 = MFMA32(av, b0, a0); a1 = MFMA32(av, b1, a1); }
    const float* rope = (const float*)(p.ws + WS_ROPE);
    bf16_t* obase = (bf16_t*)(p.ws + (kv ? WS_VC : WS_KC));
#pragma unroll
    for (int r = 0; r < 16; ++r) { const int row = rbase + crow(r, hi), c = row & 255, b = row >> 8;
        float v0 = a0[r], v1 = a1[r];
        if (kv == 0) { const float* rp = rope + (size_t)(16 * c + 31) * 64 + r32; const float cs = rp[0], sn = rp[32]; const float t0 = v0 * cs - v1 * sn, t1 = v1 * cs + v0 * sn; v0 = t0; v1 = t1; }
        if (c != 255) { bf16_t* o = obase + ((size_t)(b * 2 + g) * 256 + c) * 64 + r32; o[0] = (bf16_t)f2bf(v0); o[32] = (bf16_t)f2bf(v1); } }
}

DI f32x16 mm32(const bf16_t* A, int lda, const bf16_t* Bt, int ldb, int K, f32x16 acc, int r32, int hi) {
    for (int k0 = 0; k0 < K; k0 += 16) { const bf16x8 a = *(const bf16x8*)(A + r32 * lda + k0 + 8 * hi), b = *(const bf16x8*)(Bt + r32 * ldb + k0 + 8 * hi); acc = MFMA32(a, b, acc); }
    return acc;
}

DI void gla_vT_sts(const u32x4 v, int j, int vq, bf16_t* vT) {
#pragma unroll
    for (int e = 0; e < 4; ++e) { vT[(vq + 2 * e) * 72 + j] = (bf16_t)(v[e] & 0xffffu); vT[(vq + 2 * e + 1) * 72 + j] = (bf16_t)(v[e] >> 16); }
}
DI void gla_g1_pair(const Params& p, int l, int item0, int limit, unsigned char* lds) {
    const int tid = otid(), half = tid >> 8, t = tid & 255, lane = tid & 63, wl = (tid >> 6) & 3, r32 = lane & 31, hi = lane >> 5;
    const int item = item0 + half; const bool live = item < limit;
    const int n = item & 63, h = (item >> 6) & 3, b = item >> 8; const int T0 = b * SEQ + n * 64;
    const bf16_t* Z = (const bf16_t*)(p.ws + WS_Z);
    unsigned char* lb = lds + half * 22528;
    float* bc = (float*)lb; bf16_t* vT = (bf16_t*)(lb + 8448); bf16_t* kdT = (bf16_t*)(lb + 17664);
    const int j = t >> 2, kq = (t & 3) * 8, vq = (t & 3) * 16;
    u32x4 a0 = {}, a1 = {}, kk = {}, v0 = {}, v1 = {};
    if (live) { const bf16_t* zr = Z + (size_t)(T0 + j) * NZ;
        a0 = *(const u32x4*)(zr + ZGA); a1 = *(const u32x4*)(zr + ZGA + 8);
        kk = *(const u32x4*)(zr + ZGK + h * 32 + kq);
        v0 = *(const u32x4*)(zr + ZGV + h * 64 + vq); v1 = *(const u32x4*)(zr + ZGV + h * 64 + vq + 8); }
    if (live) {
        const float* wup = p.in[9] + (size_t)l * 16 * 128 + h * 32 + kq;
        f32x4 x0 = *(const f32x4*)(p.in[10] + l * 128 + h * 32 + kq), x1 = *(const f32x4*)(p.in[10] + l * 128 + h * 32 + kq + 4);
        float a[16];
#pragma unroll
        for (int e = 0; e < 4; ++e) { a[2 * e] = bflo(a0[e]); a[2 * e + 1] = bfhi(a0[e]); a[8 + 2 * e] = bflo(a1[e]); a[8 + 2 * e + 1] = bfhi(a1[e]); }
#pragma unroll
        for (int r = 0; r < 16; ++r) { x0 += *(const f32x4*)(wup + r * 128) * a[r]; x1 += *(const f32x4*)(wup + r * 128 + 4) * a[r]; }
#pragma unroll
        for (int e = 0; e < 4; ++e) { bc[j * 33 + kq + e] = (fminf(x0[e], 0.f) - __logf(1.0f + __expf(-fabsf(x0[e])))) * (1.0f / 16.0f);
                                      bc[j * 33 + kq + 4 + e] = (fminf(x1[e], 0.f) - __logf(1.0f + __expf(-fabsf(x1[e])))) * (1.0f / 16.0f); }
#pragma unroll
        for (int e = 0; e < 4; ++e) { vT[(vq + 2 * e) * 72 + j] = (bf16_t)(v0[e] & 0xffffu); vT[(vq + 2 * e + 1) * 72 + j] = (bf16_t)(v0[e] >> 16);
                                      vT[(vq + 8 + 2 * e) * 72 + j] = (bf16_t)(v1[e] & 0xffffu); vT[(vq + 8 + 2 * e + 1) * 72 + j] = (bf16_t)(v1[e] >> 16); }
    }
    __syncthreads();
    if (live) { float v[8];
#pragma unroll
        for (int e = 0; e < 8; ++e) v[e] = bc[lane * 33 + 8 * wl + e];
#pragma unroll
        for (int d = 1; d < 64; d <<= 1) {
#pragma unroll
            for (int e = 0; e < 8; ++e) { const float tt = __shfl_up(v[e], d); if (lane >= d) v[e] += tt; } }
#pragma unroll
        for (int e = 0; e < 8; ++e) bc[lane * 33 + 8 * wl + e] = v[e]; }
    __syncthreads();
    if (live) { const float* bp = bc + j * 33 + kq; float bv[8];
#pragma unroll
        for (int e = 0; e < 8; ++e) bv[e] = bp[e];
        float* bo = p.out + (size_t)item * 2048 + j * 32 + kq;
        *(f32x4*)bo = (f32x4){bv[0], bv[1], bv[2], bv[3]}; *(f32x4*)(bo + 4) = (f32x4){bv[4], bv[5], bv[6], bv[7]};
#pragma unroll
        for (int e = 0; e < 4; ++e) { kdT[(kq + 2 * e) * 72 + j] = (bf16_t)f2bf(bflo(kk[e]) * __expf(bc[63 * 33 + kq + 2 * e] - bv[2 * e]));
                                      kdT[(kq + 2 * e + 1) * 72 + j] = (bf16_t)f2bf(bfhi(kk[e]) * __expf(bc[63 * 33 + kq + 2 * e + 1] - bv[2 * e + 1])); } }
    __syncthreads();
    if (live) { float* gds = (float*)(p.ws + WS_GDS) + (size_t)item * 2048;
        if (wl < 2) { f32x16 acc = {}; acc = mm32(vT + wl * 32 * 72, 72, kdT, 72, 64, acc, r32, hi);
#pragma unroll
            for (int r = 0; r < 16; ++r) gds[(32 * wl + crow(r, hi)) * 32 + r32] = acc[r]; }
        if (t < 32) ((float*)(p.ws + WS_GDEC))[(size_t)item * 32 + t] = __expf(bc[63 * 33 + t]); }
    __syncthreads();
}
DI void gla_g2(const Params& p, int gt) {
    const int seq = gt >> 11, e = gt & 2047, k = e & 31;
    float* gds = (float*)(p.ws + WS_GDS) + (size_t)seq * 64 * 2048 + e; const float* dec = (const float*)(p.ws + WS_GDEC) + (size_t)seq * 64 * 32 + k;
    float s = 0.f;
#pragma unroll 8
    for (int n = 0; n < 64; ++n) { const float d = gds[(size_t)n * 2048], dc = dec[n * 32]; gds[(size_t)n * 2048] = s; s = dc * s + d; }
}
struct G3Regs { f32x4 bv, sv; u32x2 qq, kk; u32x4 vv; };
DI G3Regs gla_g3_load(const Params& p, int item, int tid) {
    const int n = item & 63, h = (item >> 6) & 3, b = item >> 8; const int T0 = b * SEQ + n * 64;
    const int i = tid >> 3, kq = (tid & 7) * 4, vq = (tid & 7) * 8;
    const bf16_t* zr = (const bf16_t*)(p.ws + WS_Z) + (size_t)(T0 + i) * NZ; G3Regs R;
    R.bv = *(const f32x4*)(p.out + (size_t)item * 2048 + i * 32 + kq);
    R.qq = *(const u32x2*)(zr + ZGQ + h * 32 + kq); R.kk = *(const u32x2*)(zr + ZGK + h * 32 + kq);
    R.sv = *(const f32x4*)((const float*)(p.ws + WS_GDS) + (size_t)item * 2048 + i * 32 + kq);
    R.vv = *(const u32x4*)(zr + ZGV + h * 64 + vq);
    return R;
}
DI void gla_g3(const Params& p, int l, int item, unsigned char* lds, int tid, const G3Regs R) {
    const int lane = tid & 63, w = tid >> 6, r32 = lane & 31, hi = lane >> 5;
    const int n = item & 63, h = (item >> 6) & 3, b = item >> 8; const int T0 = b * SEQ + n * 64;
    const bf16_t* Z = (const bf16_t*)(p.ws + WS_Z);
    bf16_t* qe = (bf16_t*)(lds + 8448); bf16_t* kt = (bf16_t*)(lds + 13568); bf16_t* St = (bf16_t*)(lds + 18688); bf16_t* vT = (bf16_t*)(lds + 23808); bf16_t* at = (bf16_t*)(lds + 33024);
    const int i = tid >> 3, kq = (tid & 7) * 4, vq = (tid & 7) * 8;
    const f32x4 bv = R.bv, sv = R.sv; const u32x2 qq = R.qq, kk = R.kk; const u32x4 vv = R.vv;
    u32x2 rr[2][4]; f32x4 gvv[2][4];
    if (w < 2) { const bf16_t* rz = Z + (size_t)(T0 + 32 * w + r32) * NZ + ZGR + h * 64; const float* gn = p.in[11] + l * 64;
#pragma unroll
        for (int vb = 0; vb < 2; ++vb)
#pragma unroll
            for (int a4 = 0; a4 < 4; ++a4) { const int v0 = 32 * vb + 8 * a4 + 4 * hi; rr[vb][a4] = *(const u32x2*)(rz + v0); gvv[vb][a4] = *(const f32x4*)(gn + v0); } }
    { const float qf[4] = {bflo(qq.x), bfhi(qq.x), bflo(qq.y), bfhi(qq.y)}, kf[4] = {bflo(kk.x), bfhi(kk.x), bflo(kk.y), bfhi(kk.y)};
#pragma unroll
      for (int e = 0; e < 4; ++e) { const float eb = __expf(bv[e]); qe[i * 40 + kq + e] = (bf16_t)f2bf(qf[e] * eb); kt[i * 40 + kq + e] = (bf16_t)f2bf(kf[e] * __expf(-bv[e])); St[i * 40 + kq + e] = (bf16_t)f2bf(sv[e]); } }
    gla_vT_sts(vv, i, vq, vT);
    __syncthreads();
    if (w < 4) { const int jb = w >> 1, ib = w & 1; f32x16 acc = {}; acc = mm32(kt + jb * 32 * 40, 40, qe + ib * 32 * 40, 40, 32, acc, r32, hi);
        const int ii = 32 * ib + r32;
#pragma unroll
        for (int a4 = 0; a4 < 4; ++a4) { const int j0 = 32 * jb + 8 * a4 + 4 * hi; float v[4];
#pragma unroll
            for (int e = 0; e < 4; ++e) v[e] = (j0 + e <= ii) ? acc[4 * a4 + e] : 0.f;
            u32x2 wv; wv.x = pk2(v[0], v[1]); wv.y = pk2(v[2], v[3]); *(u32x2*)(at + ii * 72 + j0) = wv; } }
    __syncthreads();
    if (w < 2) { const int ib = w, ii = 32 * ib + r32; f32x16 o[2];
#pragma unroll
        for (int vb = 0; vb < 2; ++vb) { o[vb] = (f32x16){}; o[vb] = mm32(St + vb * 32 * 40, 40, qe + ib * 32 * 40, 40, 32, o[vb], r32, hi); o[vb] = mm32(vT + vb * 32 * 72, 72, at + ib * 32 * 72, 72, 64, o[vb], r32, hi); }
        float ss = 0.f;
#pragma unroll
        for (int r = 0; r < 16; ++r) ss += o[0][r] * o[0][r] + o[1][r] * o[1][r];
        ss += __shfl_xor(ss, 32);
        const float rn = rsqrtf(ss * (1.0f / 64.0f) + EPS);
        bf16_t* mix = (bf16_t*)(p.ws + WS_MIX) + (size_t)(T0 + ii) * DM + 512 + h * 64;
#pragma unroll
        for (int vb = 0; vb < 2; ++vb)
#pragma unroll
            for (int a4 = 0; a4 < 4; ++a4) { const int v0 = 32 * vb + 8 * a4 + 4 * hi; const u32x2 rw = rr[vb][a4]; const f32x4 gv = gvv[vb][a4];
                const float rf[4] = {bflo(rw.x), bfhi(rw.x), bflo(rw.y), bfhi(rw.y)}; float ov[4];
#pragma unroll
                for (int e = 0; e < 4; ++e) ov[e] = o[vb][4 * a4 + e] * rn * gv[e] * siluf_(rf[e]);
                u32x2 wv; wv.x = pk2(ov[0], ov[1]); wv.y = pk2(ov[2], ov[3]); *(u32x2*)(mix + v0) = wv; } }
    __syncthreads();
}

DI void sg_item(const Params& p, int l, int item, unsigned char* lds) {
    const int tid = otid(), lane = tid & 63, w = tid >> 6, r32 = lane & 31, hi = lane >> 5;
    const int T0 = item * 128; const bf16_t* Z = (const bf16_t*)(p.ws + WS_Z); bf16_t* vT = (bf16_t*)lds;
    const int g2 = w >> 1, cb = w & 1;
    const bf16_t* sgw = (const bf16_t*)(p.ws + WS_SGW) + (size_t)(l * 4 + g2) * 128 * 128; const float* sgb = p.in[15] + (size_t)(l * 4 + g2) * 128;
    bf16x8 bfr[20]; u32x2 uu[4][4]; float bias[4];
#pragma unroll
    for (int ib = 0; ib < 4; ++ib) {
#pragma unroll
        for (int ks = 0; ks < 2 * (ib + 1); ++ks) bfr[ib * (ib + 1) + ks] = *(const bf16x8*)(sgw + (size_t)(ib * 32 + r32) * 128 + 16 * ks + 8 * hi);
        bias[ib] = sgb[ib * 32 + r32];
#pragma unroll
        for (int a4 = 0; a4 < 4; ++a4) uu[ib][a4] = *(const u32x2*)(Z + (size_t)(T0 + ib * 32 + r32) * NZ + ZUV + g2 * 64 + 32 * cb + 8 * a4 + 4 * hi);
    }
    { const int tok = tid >> 2, g = tid & 3; const bf16_t* vp = Z + (size_t)(T0 + tok) * NZ + ZUV + 256 + g * 64;
      float v[64];
#pragma unroll
      for (int c8 = 0; c8 < 8; ++c8) { const u32x4 x = *(const u32x4*)(vp + 8 * c8);
#pragma unroll
          for (int e = 0; e < 4; ++e) { v[8 * c8 + 2 * e] = bflo(x[e]); v[8 * c8 + 2 * e + 1] = bfhi(x[e]); } }
      float sm = 0.f;
#pragma unroll
      for (int c = 0; c < 64; ++c) sm += v[c];
      sm += __shfl_xor(sm, 1); sm += __shfl_xor(sm, 2);
      const float mu = sm * (1.0f / 256.0f); float q = 0.f;
#pragma unroll
      for (int c = 0; c < 64; ++c) { const float d = v[c] - mu; q += d * d; }
      q += __shfl_xor(q, 1); q += __shfl_xor(q, 2);
      const float rstd = rsqrtf(q * (1.0f / 256.0f) + EPS);
      const float* lg = p.in[12] + l * 256 + g * 64; const float* lb = p.in[13] + l * 256 + g * 64;
#pragma unroll
      for (int c = 0; c < 64; ++c) vT[(g * 64 + c) * 136 + tok] = (bf16_t)f2bf((v[c] - mu) * rstd * lg[c] + lb[c]); }
    __syncthreads();
    { bf16_t* mix = (bf16_t*)(p.ws + WS_MIX);
#pragma unroll
      for (int ib = 0; ib < 4; ++ib) { f32x16 acc = {};
#pragma unroll
          for (int ks = 0; ks < 2 * (ib + 1); ++ks) { const bf16x8 a = *(const bf16x8*)(vT + (g2 * 64 + cb * 32 + r32) * 136 + 16 * ks + 8 * hi); acc = MFMA32(a, bfr[ib * (ib + 1) + ks], acc); }
          const int i = ib * 32 + r32;
#pragma unroll
          for (int a4 = 0; a4 < 4; ++a4) { const int c0 = 32 * cb + 8 * a4 + 4 * hi; const u32x2 u2 = uu[ib][a4];
              const float uf[4] = {bflo(u2.x), bfhi(u2.x), bflo(u2.y), bfhi(u2.y)}; float ov[4];
#pragma unroll
              for (int e = 0; e < 4; ++e) ov[e] = uf[e] * (acc[4 * a4 + e] + bias[ib]);
              u32x2 wv; wv.x = pk2(ov[0], ov[1]); wv.y = pk2(ov[2], ov[3]); *(u32x2*)(mix + (size_t)(T0 + i) * DM + 768 + g2 * 64 + c0) = wv; } } }
    __syncthreads();
}

struct TileRegs { u32x4 a, b; };
DI TileRegs tile_gload_(int tid, const bf16_t* kbase, const bf16_t* vbase, int stride) {
    const int w = tid >> 6, lane = tid & 63; TileRegs t;
    if (w < 4) { const int rp = lane & 31, ch = 2 * w + (lane >> 5); const bf16_t* vp = vbase + (size_t)(2 * rp) * stride + ch * 8; t.a = *(const u32x4*)vp; t.b = *(const u32x4*)(vp + stride); }
    else { const int id = tid - 256; t.a = *(const u32x4*)(kbase + (size_t)(id >> 3) * stride + (id & 7) * 8); t.b = *(const u32x4*)(kbase + (size_t)((id >> 3) + 32) * stride + (id & 7) * 8); }
    return t;
}
DI void tile_sts_(int tid, const TileRegs& t, bf16_t* Ks, bf16_t* Vt) {
    const int w = tid >> 6, lane = tid & 63;
    if (w < 4) { const int rp = lane & 31, ch = 2 * w + (lane >> 5); unsigned* vd = (unsigned*)Vt + (ch * 8) * 34 + rp;
#pragma unroll
        for (int e = 0; e < 4; ++e) { vd[(2 * e) * 34] = (t.a[e] & 0xffffu) | (t.b[e] << 16); vd[(2 * e + 1) * 34] = (t.a[e] >> 16) | (t.b[e] & 0xffff0000u); } }
    else { const int id = tid - 256; *(u32x4*)(Ks + (id >> 3) * 72 + (id & 7) * 8) = t.a; *(u32x4*)(Ks + ((id >> 3) + 32) * 72 + (id & 7) * 8) = t.b; }
}
DI void attn_S(const bf16_t* Kb, const bf16x8 (&qr)[4], const f32x16& negm, f32x16& p0, f32x16& p1, int r32, int hi) {
#pragma unroll
    for (int d0 = 0; d0 < 4; ++d0) { const bf16x8 a0 = *(const bf16x8*)(Kb + r32 * 72 + d0 * 16 + hi * 8), a1 = *(const bf16x8*)(Kb + (32 + r32) * 72 + d0 * 16 + hi * 8);
        if (d0 == 0) { p0 = MFMA32(a0, qr[0], negm); p1 = MFMA32(a1, qr[0], negm); } else { p0 = MFMA32(a0, qr[d0], p0); p1 = MFMA32(a1, qr[d0], p1); } }
}
DI void attn_PV(const bf16_t* Vb, const f32x16& p0, const f32x16& p1, f32x16 (&o)[2], int r32, int hi, unsigned lmask) {
#pragma unroll
    for (int hf = 0; hf < 2; ++hf)
#pragma unroll
        for (int s = 0; s < 2; ++s) {
            u32x4 pw;
#pragma unroll
            for (int e = 0; e < 4; ++e) pw[e] = (hf ? pk2(p1[8 * s + 2 * e], p1[8 * s + 2 * e + 1]) : pk2(p0[8 * s + 2 * e], p0[8 * s + 2 * e + 1])) & lmask;
            const bf16x8 pb = __builtin_bit_cast(bf16x8, pw);
#pragma unroll
            for (int db = 0; db < 2; ++db) { const bf16_t* vp = Vb + (r32 + 32 * db) * 68 + 32 * hf + 16 * s + 4 * hi;
                const s16x4 lo = *(const s16x4*)vp, hh = *(const s16x4*)(vp + 8);
                const bf16x8 va = __builtin_shufflevector(lo, hh, 0, 1, 2, 3, 4, 5, 6, 7);
                o[db] = MFMA32(va, pb, o[db]); }
        }
}
DI float rowmax32(const f32x16& p0, const f32x16& p1) {
    float a = fmaxf(fmaxf(p0[0], p0[1]), p1[0]), b = fmaxf(fmaxf(p0[2], p0[3]), p1[1]); a = fmaxf(fmaxf(a, p1[2]), p1[3]);
#pragma unroll
    for (int r = 4; r < 16; r += 4) { a = fmaxf(fmaxf(a, p0[r]), p0[r + 1]); b = fmaxf(fmaxf(b, p0[r + 2]), p0[r + 3]); a = fmaxf(fmaxf(a, p1[r]), p1[r + 1]); b = fmaxf(fmaxf(b, p1[r + 2]), p1[r + 3]); }
    const float mx = fmaxf(a, b);
    return fmaxf(mx, __shfl_xor(mx, 32));
}
template <bool WITH_O>
DI void attn_softmax(f32x16& p0, f32x16& p1, float& m, float& lsum, f32x16 (&o)[2], f32x16& negm, bool on) {
    float mx = rowmax32(p0, p1);
    if (!on) mx = -INFINITY;
    if (__any(mx > 8.0f)) {
        const float dl = fmaxf(mx, 0.f), al = __builtin_amdgcn_exp2f(-dl);
        m += dl; lsum *= al;
#pragma unroll
        for (int r = 0; r < 16; ++r) { p0[r] -= dl; p1[r] -= dl; negm[r] = -m; }
        if (WITH_O) {
#pragma unroll
            for (int r = 0; r < 16; ++r) { o[0][r] *= al; o[1][r] *= al; } }
    }
    float rs0 = 0.f, rs1 = 0.f;
#pragma unroll
    for (int r = 0; r < 16; ++r) { p0[r] = __builtin_amdgcn_exp2f(p0[r]); p1[r] = __builtin_amdgcn_exp2f(p1[r]); rs0 += p0[r]; rs1 += p1[r]; }
    lsum += on ? (rs0 + rs1) : 0.f;
}
DI void mask_tri(f32x16& p0, f32x16& p1, int kind, int tql, int hi) {
#pragma unroll
    for (int r = 0; r < 16; ++r) { const int k0 = crow(r, hi), k1 = 32 + k0;
        const bool m0 = kind == 1 ? (k0 > tql) : (k0 <= tql), m1 = kind == 1 ? (k1 > tql) : (k1 <= tql);
        if (m0) p0[r] = -INFINITY; if (m1) p1[r] = -INFINITY; }
}
DI void mix_acc(bf16_t* mix, const f32x16 (&o)[2], float sc, int hi, bool add) {
#pragma unroll
    for (int db = 0; db < 2; ++db)
#pragma unroll
        for (int a4 = 0; a4 < 4; ++a4) { u32x2* mp = (u32x2*)(mix + 32 * db + 8 * a4 + 4 * hi); float v[4];
#pragma unroll
            for (int e = 0; e < 4; ++e) v[e] = o[db][4 * a4 + e] * sc;
            if (add) { const u32x2 old = *mp; v[0] += bflo(old.x); v[1] += bfhi(old.x); v[2] += bflo(old.y); v[3] += bfhi(old.y); }
            u32x2 wv; wv.x = pk2(v[0], v[1]); wv.y = pk2(v[2], v[3]); *mp = wv; }
}
#define tile_gload(...) tile_gload_(tid, __VA_ARGS__)
#define tile_sts(...) tile_sts_(tid, __VA_ARGS__)
#define ATTN_PROLOGUE \
    const int tid = otid(), lane = tid & 63, w = tid >> 6, r32 = lane & 31, hi = lane >> 5; \
    const int hq = w >> 1, tql = (w & 1) * 32 + r32, T0 = b * SEQ + qb * 64, head = g * 4 + hq; \
    const bf16_t* Z = (const bf16_t*)(p.ws + WS_Z); \
    bf16_t* Ks = (bf16_t*)lds; bf16_t* Vt = (bf16_t*)(lds + 18432); float* imp = (float*)(lds + 36864); unsigned long long* selm = (unsigned long long*)(lds + 103424); \
    const bf16_t* zrow = Z + (size_t)(T0 + tql) * NZ; \
    bf16_t* mix = (bf16_t*)(p.ws + WS_MIX) + (size_t)(T0 + tql) * DM + head * 64; \
    (void)Ks; (void)Vt; (void)imp; (void)selm; (void)mix; (void)zrow; (void)lane;
#define ATTN_Q bf16x8 qr[4]; _Pragma("unroll") for (int d0 = 0; d0 < 4; ++d0) qr[d0] = *(const bf16x8*)(zrow + ZQ + head * 64 + d0 * 16 + hi * 8); \
    f32x16 o[2]; f32x16 p0, p1, negm; float m, lsum;
DI void attn_win(const Params& p, unsigned char* lds, int b, int g, int qb) {
    ATTN_PROLOGUE ATTN_Q
    {
        const bf16_t* kb = Z + (size_t)(b * SEQ) * NZ + ZKW + g * 64; const bf16_t* vb = Z + (size_t)(b * SEQ) * NZ + ZVW + g * 64;
        const int jlo = qb >= 8 ? qb - 8 : 0; int buf = 0;
        o[0] = (f32x16){}; o[1] = (f32x16){}; negm = (f32x16){}; m = 0.f; lsum = 0.f;
        TileRegs tr = tile_gload(kb + (size_t)qb * 64 * NZ, vb + (size_t)qb * 64 * NZ, NZ), tr2 = tr;
        tile_sts(tr, Ks, Vt);
        if (qb > jlo) tr = tile_gload(kb + (size_t)(qb - 1) * 64 * NZ, vb + (size_t)(qb - 1) * 64 * NZ, NZ);
        __syncthreads();
        for (int j = qb; j >= jlo; --j) {
            if (j > jlo + 1) tr2 = tile_gload(kb + (size_t)(j - 2) * 64 * NZ, vb + (size_t)(j - 2) * 64 * NZ, NZ);
            attn_S(Ks + buf * 4608, qr, negm, p0, p1, r32, hi);
            if (j == qb) mask_tri(p0, p1, 1, tql, hi); else if (j == qb - 8) mask_tri(p0, p1, 2, tql, hi);
            attn_softmax<true>(p0, p1, m, lsum, o, negm, true);
            attn_PV(Vt + buf * 4352, p0, p1, o, r32, hi, 0xffffffffu);
            if (j > jlo) tile_sts(tr, Ks + (buf ^ 1) * 4608, Vt + (buf ^ 1) * 4352);
            __syncthreads(); buf ^= 1; tr = tr2;
        }
        lsum += __shfl_xor(lsum, 32);
        const float g_w = bf2f(zrow[ZGT + head * 3 + 2]); const float sc = lsum > 0.f ? g_w / lsum : 0.f;
        mix_acc(mix, o, sc, hi, false);
    }
}
DI void attn_cmp(const Params& p, unsigned char* lds, int b, int g, int qb) {
    ATTN_PROLOGUE ATTN_Q
    float* invl = (float*)(lds + 104448);
    const bf16_t* kc = (const bf16_t*)(p.ws + WS_KC) + (size_t)(b * 2 + g) * 256 * 64; const bf16_t* vc = (const bf16_t*)(p.ws + WS_VC) + (size_t)(b * 2 + g) * 256 * 64;
    const int ncmp = 4 * qb + 3, ntc = (ncmp + 63) >> 6; const int t = qb * 64 + tql;
    m = 0.f; lsum = 0.f; negm = (f32x16){}; o[0] = (f32x16){}; o[1] = (f32x16){};
    float carry = 0.f; int buf = 0;
    TileRegs tr = tile_gload(kc, vc, 64), tr2 = tr; tile_sts(tr, Ks, Vt);
    if (ntc > 1) tr = tile_gload(kc + (size_t)64 * 64, vc + (size_t)64 * 64, 64);
    __syncthreads();
    for (int jc = 0; jc < ntc; ++jc) {
        if (jc + 2 < ntc) tr2 = tile_gload(kc + (size_t)(jc + 2) * 64 * 64, vc + (size_t)(jc + 2) * 64 * 64, 64);
        attn_S(Ks + buf * 4608, qr, negm, p0, p1, r32, hi);
#pragma unroll
        for (int r = 0; r < 16; ++r) { const int c0 = 64 * jc + crow(r, hi), c1 = c0 + 32; if (16 * c0 + 31 > t) p0[r] = -INFINITY; if (16 * c1 + 31 > t) p1[r] = -INFINITY; }
        const float m_old = m;
        attn_softmax<true>(p0, p1, m, lsum, o, negm, true);
        if (__any(m != m_old)) {
            const float al = __builtin_amdgcn_exp2f(m_old - m); carry *= al;
            for (int nn = hi; nn < 16 * jc; nn += 2) imp[(hq * 64 + tql) * 65 + nn] *= al; }
        attn_PV(Vt + buf * 4352, p0, p1, o, r32, hi, 0xffffffffu);
#pragma unroll
        for (int hf = 0; hf < 2; ++hf) {
            float mainv[4], oth[4];
#pragma unroll
            for (int a4 = 0; a4 < 4; ++a4) { const float q0 = hf ? p1[4 * a4] : p0[4 * a4], q1 = hf ? p1[4 * a4 + 1] : p0[4 * a4 + 1], q2 = hf ? p1[4 * a4 + 2] : p0[4 * a4 + 2], q3 = hf ? p1[4 * a4 + 3] : p0[4 * a4 + 3];
                const float sp = 0.5f * q3; mainv[a4] = (q0 + q1) + (q2 + sp); oth[a4] = __shfl_xor(sp, 32); }
#pragma unroll
            for (int a4 = 0; a4 < 4; ++a4) { const float add = hi ? oth[a4] : (a4 == 0 ? carry : oth[a4 - 1]);
                imp[(hq * 64 + tql) * 65 + 16 * jc + 8 * hf + 2 * a4 + hi] = mainv[a4] + add; }
            carry = oth[3];
        }
        if (jc + 1 < ntc) tile_sts(tr, Ks + (buf ^ 1) * 4608, Vt + (buf ^ 1) * 4352);
        __syncthreads(); buf ^= 1; tr = tr2;
    }
    lsum += __shfl_xor(lsum, 32);
    const float inv_l = lsum > 0.f ? 1.0f / lsum : 0.f;
    if (hi == 0) invl[hq * 64 + tql] = inv_l;
    const float g_c = bf2f(zrow[ZGT + head * 3 + 0]); mix_acc(mix, o, g_c * inv_l, hi, false);
    __syncthreads();
}
DI void attn_topk(const Params& p, unsigned char* lds, int b, int g, int qb, int sel_off) {
    ATTN_PROLOGUE
    {
        const int n = lane; const bool valid = n <= qb, forced = (n == 0) | (n == qb) | (n == qb - 1), cand = valid && !forced;
        unsigned kb[8];
#pragma unroll
        for (int tt = 0; tt < 8; ++tt) { const int tok = w * 8 + tt;
            const float* il = (const float*)(lds + 104448) + tok;
            const float sc = ((imp[(0 * 64 + tok) * 65 + n] * il[0] + imp[(1 * 64 + tok) * 65 + n] * il[64]) + imp[(2 * 64 + tok) * 65 + n] * il[128]) + imp[(3 * 64 + tok) * 65 + n] * il[192];
            kb[tt] = cand ? (__float_as_uint(sc) + 1u) : 0u; }
        if (qb >= 16) {
            unsigned T[8] = {0u, 0u, 0u, 0u, 0u, 0u, 0u, 0u};
            for (int bit = 30; bit >= 0; --bit) {
#pragma unroll
                for (int tt = 0; tt < 8; ++tt) { const unsigned c2 = T[tt] | (1u << bit); if (__popcll(__ballot(kb[tt] >= c2)) >= 13) T[tt] = c2; }
            }
#pragma unroll
            for (int tt = 0; tt < 8; ++tt) { const unsigned long long gtm = __ballot(kb[tt] > T[tt]), eqm = __ballot(kb[tt] == T[tt]);
                const int need = 13 - __popcll(gtm), rk = __popcll(eqm & ((1ull << n) - 1ull));
                const bool sel = forced || (cand && (kb[tt] > T[tt] || (kb[tt] == T[tt] && rk < need)));
                const unsigned long long mask = __ballot(sel);
                if (lane == 0) selm[sel_off + w * 8 + tt] = mask; }
        } else {
            const unsigned long long mask = __ballot(valid);
            if (lane < 8) selm[sel_off + w * 8 + lane] = mask;
        }
        __syncthreads();
    }
}
DI void attn_sel(const Params& p, unsigned char* lds, int b, int g, int qb) {
    ATTN_PROLOGUE ATTN_Q
    {
        unsigned long long bm = selm[lane];
#pragma unroll
        for (int o_ = 1; o_ < 64; o_ <<= 1) { const unsigned lo = __shfl_xor((unsigned)bm, o_), hh = __shfl_xor((unsigned)(bm >> 32), o_); bm |= ((unsigned long long)hh << 32) | lo; }
        const unsigned bmlo = __builtin_amdgcn_readfirstlane((unsigned)bm), bmhi = __builtin_amdgcn_readfirstlane((unsigned)(bm >> 32));
        unsigned long long rem = (((unsigned long long)bmhi << 32) | bmlo) | 1ull;
        const unsigned long long mysel = selm[tql];
        const bf16_t* kb = Z + (size_t)(b * SEQ) * NZ + ZKS + g * 64; const bf16_t* vb = Z + (size_t)(b * SEQ) * NZ + ZVS + g * 64;
        o[0] = (f32x16){}; o[1] = (f32x16){}; negm = (f32x16){}; m = 0.f; lsum = 0.f; int buf = 0;
        int j = __builtin_ctzll(rem); rem &= rem - 1;
        int jn = rem ? __builtin_ctzll(rem) : -1; rem &= rem - 1;
        TileRegs tr = tile_gload(kb + (size_t)j * 64 * NZ, vb + (size_t)j * 64 * NZ, NZ), tr2 = tr; tile_sts(tr, Ks, Vt);
        if (jn >= 0) tr = tile_gload(kb + (size_t)jn * 64 * NZ, vb + (size_t)jn * 64 * NZ, NZ);
        __syncthreads();
        for (;;) {
            const int jnn = rem ? __builtin_ctzll(rem) : -1; rem &= rem - 1;
            if (jnn >= 0) tr2 = tile_gload(kb + (size_t)jnn * 64 * NZ, vb + (size_t)jnn * 64 * NZ, NZ);
            attn_S(Ks + buf * 4608, qr, negm, p0, p1, r32, hi);
            if (j == qb) mask_tri(p0, p1, 1, tql, hi);
            const bool on = (mysel >> j) & 1ull;
            attn_softmax<true>(p0, p1, m, lsum, o, negm, on);
            attn_PV(Vt + buf * 4352, p0, p1, o, r32, hi, on ? 0xffffffffu : 0u);
            if (jn >= 0) tile_sts(tr, Ks + (buf ^ 1) * 4608, Vt + (buf ^ 1) * 4352);
            __syncthreads(); buf ^= 1;
            if (jn < 0) break; j = jn; jn = jnn; tr = tr2;
        }
        lsum += __shfl_xor(lsum, 32);
        const float g_s = bf2f(zrow[ZGT + head * 3 + 1]); const float sc = lsum > 0.f ? g_s / lsum : 0.f;
        mix_acc(mix, o, sc, hi, true);
    }
}


DI void softmax_pack(f32x16& p0, f32x16& p1, float& m, float& lsum, f32x16 (&o)[2], bool& shifted, bool on, u32x4 (&pw)[4]) {
    if (shifted) {
#pragma unroll
        for (int r = 0; r < 16; ++r) { p0[r] -= m; p1[r] -= m; } }
    float mx = rowmax32(p0, p1);
    if (!on) mx = -INFINITY;
    if (__any(mx > 8.0f)) {
        shifted = true;
        const float dl = fmaxf(mx, 0.f), al = __builtin_amdgcn_exp2f(-dl);
        m += dl; lsum *= al;
#pragma unroll
        for (int r = 0; r < 16; ++r) { p0[r] -= dl; p1[r] -= dl; o[0][r] *= al; o[1][r] *= al; }
    }
    float rs0 = 0.f, rs1 = 0.f;
#pragma unroll
    for (int r = 0; r < 16; ++r) { p0[r] = __builtin_amdgcn_exp2f(p0[r]); p1[r] = __builtin_amdgcn_exp2f(p1[r]); rs0 += p0[r]; rs1 += p1[r]; }
    lsum += on ? (rs0 + rs1) : 0.f;
    const unsigned lmask = on ? 0xffffffffu : 0u;
#pragma unroll
    for (int s = 0; s < 2; ++s)
#pragma unroll
        for (int e = 0; e < 4; ++e) { pw[s][e] = pk2(p0[8 * s + 2 * e], p0[8 * s + 2 * e + 1]) & lmask; pw[2 + s][e] = pk2(p1[8 * s + 2 * e], p1[8 * s + 2 * e + 1]) & lmask; }
}
DI void S_pair(const bf16_t* Kb, const bf16x8 (&qa)[4], const bf16x8* qbl, f32x16& a0, f32x16& a1, f32x16& b0, f32x16& b1, int r32, int hi) {
    { const bf16x8 k0 = *(const bf16x8*)(Kb + r32 * 72 + hi * 8), k1 = *(const bf16x8*)(Kb + (32 + r32) * 72 + hi * 8); const bf16x8 qv = qbl[0];
      a0 = MFMA32(k0, qa[0], (f32x16){}); a1 = MFMA32(k1, qa[0], (f32x16){}); b0 = MFMA32(k0, qv, (f32x16){}); b1 = MFMA32(k1, qv, (f32x16){}); }
#pragma unroll
    for (int d0 = 1; d0 < 4; ++d0) { const bf16x8 k0 = *(const bf16x8*)(Kb + r32 * 72 + d0 * 16 + hi * 8), k1 = *(const bf16x8*)(Kb + (32 + r32) * 72 + d0 * 16 + hi * 8); const bf16x8 qv = qbl[d0 * 512];
        a0 = MFMA32(k0, qa[d0], a0); a1 = MFMA32(k1, qa[d0], a1); b0 = MFMA32(k0, qv, b0); b1 = MFMA32(k1, qv, b1); }
}
DI void PV_pair(const bf16_t* Vb, const u32x4 (&pwa)[4], const u32x4 (&pwb)[4], f32x16 (&oa)[2], f32x16 (&ob)[2], int r32, int hi) {
#pragma unroll
    for (int hs = 0; hs < 4; ++hs) { const int hf = hs >> 1, s = hs & 1;
        const bf16x8 pa = __builtin_bit_cast(bf16x8, pwa[hs]), pb = __builtin_bit_cast(bf16x8, pwb[hs]);
#pragma unroll
        for (int db = 0; db < 2; ++db) { const bf16_t* vp = Vb + (r32 + 32 * db) * 68 + 32 * hf + 16 * s + 4 * hi;
            const s16x4 lo = *(const s16x4*)vp, hh = *(const s16x4*)(vp + 8);
            const bf16x8 va = __builtin_shufflevector(lo, hh, 0, 1, 2, 3, 4, 5, 6, 7);
            oa[db] = MFMA32(va, pa, oa[db]);
            ob[db] = MFMA32(va, pb, ob[db]); }
        __builtin_amdgcn_sched_barrier(0);
    }
}
#define PAIR_PROLOGUE \
    const int tid = otid(), lane = tid & 63, w = tid >> 6, r32 = lane & 31, hi = lane >> 5; \
    const int hq = w >> 1, tql = (w & 1) * 32 + r32, head = g * 4 + hq, qb1 = qb0 + 1; \
    const bf16_t* Z = (const bf16_t*)(p.ws + WS_Z); \
    bf16_t* Ks = (bf16_t*)lds; bf16_t* Vt = (bf16_t*)(lds + 18432); unsigned long long* selm = (unsigned long long*)(lds + 103424); (void)selm; \
    const bf16_t* zrA = Z + (size_t)(b * SEQ + qb0 * 64 + tql) * NZ; const bf16_t* zrB = zrA + (size_t)64 * NZ; \
    bf16_t* mixA = (bf16_t*)(p.ws + WS_MIX) + (size_t)(b * SEQ + qb0 * 64 + tql) * DM + head * 64; bf16_t* mixB = mixA + (size_t)64 * DM; \
    bf16x8 qA[4]; bf16x8* qBl = (bf16x8*)(lds + 104448) + tid; _Pragma("unroll") for (int d0 = 0; d0 < 4; ++d0) { qA[d0] = *(const bf16x8*)(zrA + ZQ + head * 64 + d0 * 16 + hi * 8); qBl[d0 * 512] = *(const bf16x8*)(zrB + ZQ + head * 64 + d0 * 16 + hi * 8); } \
    f32x16 oA[2] = {(f32x16){}, (f32x16){}}, oB[2] = {(f32x16){}, (f32x16){}}; f32x16 pa0, pa1, pb0, pb1; float mA = 0.f, mB = 0.f, lA = 0.f, lB = 0.f; bool shA = false, shB = false; \
    u32x4 pwA[4], pwB[4];
DI void attn_win2(const Params& p, unsigned char* lds, int b, int g, int qb0) {
    PAIR_PROLOGUE
    const bf16_t* kb = Z + (size_t)(b * SEQ) * NZ + ZKW + g * 64; const bf16_t* vb = Z + (size_t)(b * SEQ) * NZ + ZVW + g * 64;
    const int jlo = qb0 >= 8 ? qb0 - 8 : 0; int buf = 0;
    { TileRegs tr = tile_gload(kb + (size_t)qb1 * 64 * NZ, vb + (size_t)qb1 * 64 * NZ, NZ); tile_sts(tr, Ks, Vt); }
    __syncthreads();
    for (int j = qb1; j >= jlo; --j) {
        TileRegs tr; if (j > jlo) tr = tile_gload(kb + (size_t)(j - 1) * 64 * NZ, vb + (size_t)(j - 1) * 64 * NZ, NZ);
        const bool ra = (j <= qb0) && (j >= qb0 - 8), rb = (j >= qb1 - 8);
        S_pair(Ks + buf * 4608, qA, qBl, pa0, pa1, pb0, pb1, r32, hi);
        if (j == qb0) mask_tri(pa0, pa1, 1, tql, hi); else if (j == qb0 - 8) mask_tri(pa0, pa1, 2, tql, hi);
        softmax_pack(pa0, pa1, mA, lA, oA, shA, ra, pwA);
        if (j == qb1) mask_tri(pb0, pb1, 1, tql, hi); else if (j == qb1 - 8) mask_tri(pb0, pb1, 2, tql, hi);
        softmax_pack(pb0, pb1, mB, lB, oB, shB, rb, pwB);
        PV_pair(Vt + buf * 4352, pwA, pwB, oA, oB, r32, hi);
        if (j > jlo) tile_sts(tr, Ks + (buf ^ 1) * 4608, Vt + (buf ^ 1) * 4352);
        __syncthreads(); buf ^= 1;
    }
    lA += __shfl_xor(lA, 32); lB += __shfl_xor(lB, 32);
    const float gA = bf2f(zrA[ZGT + head * 3 + 2]), gB = bf2f(zrB[ZGT + head * 3 + 2]);
    mix_acc(mixA, oA, lA > 0.f ? gA / lA : 0.f, hi, true); mix_acc(mixB, oB, lB > 0.f ? gB / lB : 0.f, hi, true);
}
DI void attn_sel2(const Params& p, unsigned char* lds, int b, int g, int qb0) {
    PAIR_PROLOGUE
    unsigned long long bm = selm[lane] | selm[64 + lane];
#pragma unroll
    for (int o_ = 1; o_ < 64; o_ <<= 1) { const unsigned lo = __shfl_xor((unsigned)bm, o_), hh = __shfl_xor((unsigned)(bm >> 32), o_); bm |= ((unsigned long long)hh << 32) | lo; }
    const unsigned bmlo = __builtin_amdgcn_readfirstlane((unsigned)bm), bmhi = __builtin_amdgcn_readfirstlane((unsigned)(bm >> 32));
    unsigned long long rem = (((unsigned long long)bmhi << 32) | bmlo) | 1ull;
    const unsigned long long selA = selm[tql], selB = selm[64 + tql];
    const bf16_t* kb = Z + (size_t)(b * SEQ) * NZ + ZKS + g * 64; const bf16_t* vb = Z + (size_t)(b * SEQ) * NZ + ZVS + g * 64;
    int buf = 0;
    int j = __builtin_ctzll(rem); rem &= rem - 1;
    { TileRegs tr = tile_gload(kb + (size_t)j * 64 * NZ, vb + (size_t)j * 64 * NZ, NZ); tile_sts(tr, Ks, Vt); }
    __syncthreads();
    for (;;) {
        const int jn = rem ? __builtin_ctzll(rem) : -1; rem &= rem - 1;
        TileRegs tr; if (jn >= 0) tr = tile_gload(kb + (size_t)jn * 64 * NZ, vb + (size_t)jn * 64 * NZ, NZ);
        const bool ra = j <= qb0;
        S_pair(Ks + buf * 4608, qA, qBl, pa0, pa1, pb0, pb1, r32, hi);
        if (j == qb0) mask_tri(pa0, pa1, 1, tql, hi);
        softmax_pack(pa0, pa1, mA, lA, oA, shA, ra && ((selA >> j) & 1ull), pwA);
        if (j == qb1) mask_tri(pb0, pb1, 1, tql, hi);
        softmax_pack(pb0, pb1, mB, lB, oB, shB, (selB >> j) & 1ull, pwB);
        PV_pair(Vt + buf * 4352, pwA, pwB, oA, oB, r32, hi);
        if (jn >= 0) tile_sts(tr, Ks + (buf ^ 1) * 4608, Vt + (buf ^ 1) * 4352);
        __syncthreads(); buf ^= 1;
        if (jn < 0) break; j = jn;
    }
    lA += __shfl_xor(lA, 32); lB += __shfl_xor(lB, 32);
    const float gA = bf2f(zrA[ZGT + head * 3 + 1]), gB = bf2f(zrB[ZGT + head * 3 + 1]);
    mix_acc(mixA, oA, lA > 0.f ? gA / lA : 0.f, hi, true); mix_acc(mixB, oB, lB > 0.f ? gB / lB : 0.f, hi, true);
}
DI void attn_pair(const Params& p, unsigned char* lds, int b, int g, int qp) {
    const int qb0 = 2 * qp;
    attn_cmp(p, lds, b, g, qb0); attn_topk(p, lds, b, g, qb0, 0);
    attn_cmp(p, lds, b, g, qb0 + 1); attn_topk(p, lds, b, g, qb0 + 1, 64);
    attn_win2(p, lds, b, g, qb0);
    attn_sel2(p, lds, b, g, qb0);
}

#define XB_TMO      128
#define XB_XCNT(j)  (256  + 64 * (j))
#define XB_XSUB(j)  (1280 + 64 * (j))
#define XB_XGEN(j)  (2304 + 64 * (j))
#define XB_TOP      3328
#define XB_TOPGEN   3392
#define XCD_BAR_WORDS 3456
#define XB_SPIN_CAP (1u << 22)
DI unsigned xb_ld(unsigned* p)              { return __hip_atomic_load(p, __ATOMIC_RELAXED, __HIP_MEMORY_SCOPE_AGENT); }
DI unsigned xb_add(unsigned* p, unsigned v) { return __hip_atomic_fetch_add(p, v, __ATOMIC_RELAXED, __HIP_MEMORY_SCOPE_AGENT); }
DI unsigned xb_xcc_id() { return (unsigned)__builtin_amdgcn_s_getreg((3 << 11) | 20) & 0xFu; }
#define XB_SPIN(cond, bar) do { unsigned _sp = 0; while (cond) { __builtin_amdgcn_s_sleep(1); \
    if ((++_sp & 255u) == 0u) { if (xb_ld(&(bar)[XB_TMO])) break; if (_sp > XB_SPIN_CAP) { atomicAdd(&(bar)[XB_TMO], 1u); break; } } } } while (0)
struct XcdBarrier { unsigned* bar; unsigned x; volatile LAS unsigned* st; };
DI XcdBarrier xcd_barrier_post(unsigned* bar, volatile LAS unsigned* st) {
    XcdBarrier b; b.bar = bar; b.x = xb_xcc_id(); b.st = st;
    if (threadIdx.x == 0) (void)xb_add(&bar[XB_XCNT(b.x)], 1u);
    return b;
}
DI void xcd_barrier_complete(unsigned* bar, unsigned x, unsigned& nloc, unsigned& nx) {
    const unsigned G = gridDim.x * gridDim.y * gridDim.z;
    unsigned sum, cnt, mine, sp = 0u;
    for (;;) {
        sum = 0u; cnt = 0u; mine = 0u;
#pragma unroll
        for (unsigned j = 0; j < 16; ++j) { const unsigned c = xb_ld(&bar[XB_XCNT(j)]); sum += c; cnt += (c > 0u) ? 1u : 0u; mine = (j == x) ? c : mine; }
        if (sum == G) break;
        __builtin_amdgcn_s_sleep(1);
        if ((++sp & 255u) == 0u) { if (xb_ld(&bar[XB_TMO])) break; if (sp > XB_SPIN_CAP) { atomicAdd(&bar[XB_TMO], 1u); break; } }
    }
    nloc = mine > 0u ? mine : 1u; nx = cnt > 0u ? cnt : 1u;
}
DI void xcd_barrier(const XcdBarrier& b) {
    asm volatile("s_waitcnt vmcnt(0)" ::: "memory");
    __syncthreads();
    if (threadIdx.x == 0) {
        unsigned* bar = b.bar;
        __builtin_amdgcn_s_waitcnt(0);
        unsigned nloc = b.st[0], nx = b.st[1];
        if (nloc == 0u) { xcd_barrier_complete(bar, b.x, nloc, nx); b.st[0] = nloc; b.st[1] = nx; }
        const unsigned old = xb_add(&bar[XB_XSUB(b.x)], 1u);
        const unsigned gen = old / nloc;
        if (old + 1u == (gen + 1u) * nloc) {
            __builtin_amdgcn_fence(__ATOMIC_RELEASE, "agent");
            asm volatile("s_waitcnt vmcnt(0)" ::: "memory");
            const unsigned og = xb_add(&bar[XB_TOP], 1u);
            const unsigned tg = og / nx;
            if (og + 1u == (tg + 1u) * nx) xb_add(&bar[XB_TOPGEN], 1u);
            else XB_SPIN(xb_ld(&bar[XB_TOPGEN]) == tg, bar);
            __builtin_amdgcn_fence(__ATOMIC_ACQUIRE, "agent");
            xb_add(&bar[XB_XGEN(b.x)], 1u);
            asm volatile("s_waitcnt vmcnt(0)" ::: "memory");
        } else {
            XB_SPIN(xb_ld(&bar[XB_XGEN(b.x)]) == gen, bar);
            __builtin_amdgcn_fence(__ATOMIC_ACQUIRE, "agent");
            asm volatile("s_waitcnt vmcnt(0)" ::: "memory");
        }
    }
    __syncthreads();
}

#ifndef PH_MASK
#define PH_MASK 0xFFFF
#endif
#define PH(b) ((PH_MASK >> (b)) & 1)
#ifndef DUP_MASK
#define DUP_MASK 0
#endif
#define REP(b) for (int rep_ = 0; rep_ < 1 + ((DUP_MASK >> (b)) & 1); ++rep_)
__global__ void __launch_bounds__(512, 2) hybrid_fwd(Params p) {
    extern __shared__ __attribute__((aligned(16))) unsigned char lds[];
    cg::grid_group grid_ = cg::this_grid();
    LAS unsigned char* ldsl = (LAS unsigned char*)lds;
    unsigned char* ws = p.ws;
    const int G = gridDim.x, bx = blockIdx.x, tid = threadIdx.x;
    bf16_t* Zb = (bf16_t*)(ws + WS_Z); bf16_t* XB = (bf16_t*)(ws + WS_XB); bf16_t* MIX = (bf16_t*)(ws + WS_MIX); bf16_t* HF = Zb;
    bf16_t* XLp = (bf16_t*)(ws + WS_XL);
    float* ssqA = (float*)(ws + WS_SSQA); float* ssqB = (float*)(ws + WS_SSQB);

    volatile LAS unsigned* MISC = (volatile LAS unsigned*)(ldsl + LDS_MISC);
    if (tid < 64) MISC[tid] = 0u;
    if (bx == 0) for (int i = tid; i < 16384; i += 512) ((unsigned*)(ws + WS_CTL))[i] = 0u;
    __syncthreads();
    REP(0) if (PH(0)) phase0(p, lds);
    grid_.sync();
    const XcdBarrier xbar = xcd_barrier_post((unsigned*)(ws + WS_CTL), MISC + 8);
    struct GS { const XcdBarrier& b; DI void sync() const { xcd_barrier(b); } } grid{xbar};
    for (int l = 0; l < NL; ++l) {
        REP(1) if (PH(1)) { pg8::Gemm g{XB, (const bf16_t*)(ws + WS_WIN) + (size_t)l * NZ * WP, DM, DM * 2, 128, WP * 2}; pg8::StaticOrder S; S.init(MTOK, NZ, G, bx);
          EpiIn E{Zb, ssqA, (const float*)(ws + WS_ROPE)}; pg8::gemm_phase(ldsl, g, S, E); }
        grid.sync();
        REP(2) if (!PH(2)) {} else if (bx < 32) {
            const int set = bx >> 3, kv = set >> 1, gg = set & 1;
            pg8::Gemm g{Zb + (kv ? ZVC : ZKC) + gg * 64, (const bf16_t*)(ws + WS_WC1) + (size_t)(l * 2 + kv) * 256 * WPC, 2048, 16u * NZ * 2u, (unsigned)NZ * 2u, WPC * 2};
            pg8::OneUnit S{bx & 7}; EpiCmp E{(bf16_t*)(ws + WS_CH) + (size_t)set * 2048 * 256, (const float*)(ws + WS_POSB) + (l * 2 + kv) * 256};
            pg8::gemm_phase(ldsl, g, S, E);
        } else {
            REP(3) if (PH(3)) { sg_item(p, l, bx - 32, lds); if (bx >= G - 32) sg_item(p, l, bx - 32 + 32, lds); }
            REP(4) if (PH(4)) for (int it = 2 * (bx - 32); it < 2048; it += 2 * (G - 32)) gla_g1_pair(p, l, it, 2048, lds);
        }
        grid.sync();
        { const int t2 = otid(); if (PH(5) && bx < 128) gla_g2(p, bx * 512 + t2); else if (bx < 160) compress2(p, l, (bx - 128) >> 3, (bx - 128) & 7); }
        grid.sync();
        { const int xcd = bx & 7, cu = bx >> 3; const int bg = xcd * 2 + (cu >> 4), s = cu & 15;
          REP(6) if (PH(6)) for (int i = 0; i < 2; ++i) { const int qp = i ? s : 31 - s; attn_pair(p, lds, bg >> 1, bg & 1, qp); __syncthreads(); }
          REP(7) if (PH(7)) { const int t3 = otid(); int it = bx; G3Regs cur = gla_g3_load(p, it, t3);
              for (;;) { const int nx = it + G; G3Regs nxt = cur; if (nx < 2048) nxt = gla_g3_load(p, nx, t3);
                  gla_g3(p, l, it, lds, t3, cur); if (nx >= 2048) break; cur = nxt; it = nx; } } }
        grid.sync();
        if (PH(8)) { pg8::Gemm g{MIX, (const bf16_t*)(ws + WS_WOUT) + (size_t)l * DM * WP, DM, DM * 2, 128, WP * 2}; pg8::StaticOrder S; S.init(MTOK, DM, G, bx);
          EpiRes E{XB, XLp, ssqB}; pg8::gemm_phase(ldsl, g, S, E); }
        grid.sync();
        REP(9) if (PH(9)) { pg8::Gemm g{XB, (const bf16_t*)(ws + WS_WGU) + (size_t)l * 2 * DFF * WP, DM, DM * 2, 128, WP * 2}; pg8::StaticOrder S; S.init(MTOK, 2 * DFF, G, bx);
          EpiGlu E{HF, ssqB}; pg8::gemm_phase(ldsl, g, S, E); }
        grid.sync();
        if (PH(10)) { pg8::Gemm g{HF, (const bf16_t*)(ws + WS_WDN) + (size_t)l * DM * DFF, DFF, DFF * 2, 128, 0}; pg8::StaticOrder S; S.init(MTOK, DM, G, bx);
          EpiRes E{XB, XLp, ssqA}; pg8::gemm_phase(ldsl, g, S, E); }
        grid.sync();
    }
    { const int lane = tid & 63, gw = bx * 8 + (tid >> 6), NGW = G * 8; const float* fg = p.in[21];
      for (int mrow = gw; mrow < MTOK; mrow += NGW) { const u32x2* hr = (const u32x2*)(XB + (size_t)mrow * DM) + lane; const u32x2* lr = (const u32x2*)(XLp + (size_t)mrow * DM) + lane; f32x4* xo = (f32x4*)(p.out + (size_t)mrow * DM) + lane; f32x4 v[4]; float s = 0.f;
#pragma unroll
          for (int j = 0; j < 4; ++j) { const u32x2 h = hr[64 * j], lw = lr[64 * j]; v[j] = (f32x4){bflo(h.x) + bflo(lw.x), bfhi(h.x) + bfhi(lw.x), bflo(h.y) + bflo(lw.y), bfhi(h.y) + bfhi(lw.y)}; s += (v[j].x * v[j].x + v[j].y * v[j].y) + (v[j].z * v[j].z + v[j].w * v[j].w); }
          const float rinv = rsqrtf(wave_sum(s) * (1.0f / DM) + EPS);
#pragma unroll
          for (int j = 0; j < 4; ++j) { const f32x4 gv = *((const f32x4*)fg + lane + 64 * j); xo[64 * j] = v[j] * rinv * gv; } } }
}

extern "C" void kernel_launch(void* const* d_in, const int* in_sizes, int n_in, void* d_out, int out_size, void* d_ws, size_t ws_size, hipStream_t stream) {
    static int grid = 0;
    if (grid == 0) {
        if (n_in != 22 || out_size != MTOK * DM || ws_size < WS_END) { fprintf(stderr, "kernel_launch: unexpected shapes (n_in %d out %d ws %zu need %zu)\n", n_in, out_size, ws_size, (size_t)WS_END); grid = -1; return; }
        int dev = 0, cus = 0, per_cu = 0;
        hipGetDevice(&dev); hipDeviceGetAttribute(&cus, hipDeviceAttributeMultiprocessorCount, dev);
        hipFuncSetAttribute((const void*)hybrid_fwd, hipFuncAttributeMaxDynamicSharedMemorySize, LDS_BYTES);
        hipOccupancyMaxActiveBlocksPerMultiprocessor(&per_cu, (const void*)hybrid_fwd, 512, LDS_BYTES);
        if (per_cu < 1) { fprintf(stderr, "kernel_launch: occupancy query says %d blocks/CU\n", per_cu); per_cu = 1; }
        grid = cus;
        if (grid != 256) fprintf(stderr, "kernel_launch: note: %d CUs\n", grid);
    }
    if (grid < 0) return;
    Params p{};
    for (int i = 0; i < 22; ++i) p.in[i] = (const float*)d_in[i];
    p.out = (float*)d_out; p.ws = (unsigned char*)d_ws;
    void* args[] = {&p};
    hipError_t e = hipLaunchCooperativeKernel((const void*)hybrid_fwd, dim3(grid), dim3(512), args, LDS_BYTES, stream);
    if (e != hipSuccess) fprintf(stderr, "cooperative launch failed: %s (grid %d)\n", hipGetErrorString(e), grid);
}
```

```cpp
#include <hip/hip_runtime.h>
#include <hip/hip_cooperative_groups.h>
#include <cstdio>
#include <cstdint>
#include <cmath>
namespace cg = cooperative_groups;

#define LAS __attribute__((address_space(3)))
typedef unsigned short bf16_t;
typedef short bf16x8 __attribute__((ext_vector_type(8)));
typedef short s16x4 __attribute__((ext_vector_type(4)));
typedef float f32x4 __attribute__((ext_vector_type(4)));
typedef float f32x2 __attribute__((ext_vector_type(2)));
typedef float f32x16 __attribute__((ext_vector_type(16)));
typedef unsigned u32x4 __attribute__((ext_vector_type(4)));
typedef unsigned u32x2 __attribute__((ext_vector_type(2)));
typedef __bf16 bf16x2_t __attribute__((ext_vector_type(2)));
#define DI __device__ __forceinline__

constexpr int BATCH = 8, SEQ = 4096, DM = 1024, NL = 4, MTOK = BATCH * SEQ;
constexpr int NZ = 2816, DFF = 2816, DIN = 2600;
constexpr int ZQ = 0, ZKC = 512, ZVC = 640, ZKS = 768, ZVS = 896, ZKW = 1024, ZVW = 1152, ZGQ = 1280, ZGK = 1408, ZGV = 1536, ZGR = 1792, ZUV = 2048, ZGT = 2560, ZGA = 2592;
constexpr float EPS = 1e-6f;
constexpr float QSCALE = 0.125f * 1.4426950408889634f;

constexpr size_t al256(size_t x) { return (x + 255) & ~(size_t)255; }
constexpr int WP = DM + 64, WPC = 2048 + 64;
constexpr size_t WS_WIN = 0;
constexpr size_t WS_WOUT = WS_WIN + al256((size_t)NL * NZ * WP * 2);
constexpr size_t WS_WGU = WS_WOUT + al256((size_t)NL * DM * WP * 2);
constexpr size_t WS_WDN = WS_WGU + al256((size_t)NL * 2 * DFF * WP * 2);
constexpr size_t WS_WC1 = WS_WDN + al256((size_t)NL * DM * DFF * 2);
constexpr size_t WS_SGW = WS_WC1 + al256((size_t)NL * 2 * 256 * WPC * 2);
constexpr size_t WS_ROPE = WS_SGW + al256((size_t)NL * 4 * 128 * 128 * 2);
constexpr size_t WS_POSB = WS_ROPE + al256((size_t)4096 * 64 * 4);
constexpr size_t WS_XB = WS_POSB + al256((size_t)NL * 2 * 256 * 4);
constexpr size_t WS_SSQA = WS_XB + al256((size_t)MTOK * DM * 2);
constexpr size_t WS_SSQB = WS_SSQA + al256((size_t)MTOK * 16 * 4);
constexpr size_t WS_Z = WS_SSQB + al256((size_t)MTOK * 16 * 4);
constexpr size_t WS_MIX = WS_Z + al256((size_t)(MTOK + 64) * NZ * 2);
constexpr size_t WS_CH = WS_MIX + al256((size_t)MTOK * DM * 2);
constexpr size_t WS_KC = WS_CH + al256((size_t)4 * 2048 * 256 * 2);
constexpr size_t WS_VC = WS_KC + al256((size_t)16 * 256 * 64 * 2);
constexpr size_t WS_GDS = WS_VC + al256((size_t)16 * 256 * 64 * 2);
constexpr size_t WS_GDEC = WS_GDS + al256((size_t)2048 * 2048 * 4);
constexpr size_t WS_W2T = WS_GDEC + al256((size_t)2048 * 32 * 4);
constexpr size_t WS_XL = WS_W2T + al256((size_t)NL * 2 * 64 * 256 * 2);
constexpr size_t WS_CTL = WS_XL + al256((size_t)MTOK * DM * 2);
constexpr size_t WS_END = WS_CTL + 65536;

constexpr int LDS_MISC = 139264;
constexpr int LDS_BYTES = LDS_MISC + 4096;

DI unsigned f2bf(float f) { unsigned u = __builtin_bit_cast(unsigned, f); return (u + 0x7fffu + ((u >> 16) & 1u)) >> 16; }
DI float bf2f(unsigned short h) { return __builtin_bit_cast(float, (unsigned)h << 16); }
DI unsigned pk2(float lo, float hi) { f32x2 v = {lo, hi}; bf16x2_t b = __builtin_convertvector(v, bf16x2_t); return __builtin_bit_cast(unsigned, b); }
DI float bflo(unsigned w) { return __builtin_bit_cast(float, w << 16); }
DI float bfhi(unsigned w) { return __builtin_bit_cast(float, w & 0xffff0000u); }
DI float wave_sum(float v) {
#pragma unroll
    for (int o = 1; o < 64; o <<= 1) v += __shfl_xor(v, o);
    return v;
}
DI float gelu_tanh(float x) { const float u = x * __builtin_fmaf(x * x, -0.10294324f, -2.3022082f); return x * __builtin_amdgcn_rcpf(1.0f + __builtin_amdgcn_exp2f(u)); }
DI float sigmoidf_(float x) { return __builtin_amdgcn_rcpf(1.0f + __builtin_amdgcn_exp2f(-1.4426950408889634f * x)); }
DI float siluf_(float x) { return x * __builtin_amdgcn_rcpf(1.0f + __builtin_amdgcn_exp2f(-1.4426950408889634f * x)); }
DI int otid() { int t = threadIdx.x; asm volatile("" : "+v"(t)); return t; }
DI int crow(int r, int hi) { return (r & 3) + 8 * (r >> 2) + 4 * hi; }
#define MFMA32(a, b, c) __builtin_amdgcn_mfma_f32_32x32x16_bf16((a), (b), (c), 0, 0, 0)

struct Params {
    const float* in[22];
    float* out;
    unsigned char* ws;
};

namespace pg8 {
constexpr int BM = 256, BK = 64, HALF = 128, HTB = HALF * BK * 2, STAGE_BYTES = 8 * HTB, NXCD = 8, WGM = 4;
__host__ __device__ __forceinline__ int lds_byte(int r, int c) { const int st = (r >> 4) * 2 + (c >> 5), rr = r & 15, cc = c & 31, ob = rr * 64 + cc * 2; return st * 1024 + (ob ^ (((ob >> 9) & 1) << 5)); }
__host__ __device__ __forceinline__ void stage_rc(int b, int& R, int& C) { const int st = b / 1024, sb = b % 1024, swz = sb ^ (((sb >> 9) & 1) << 5); R = (st >> 1) * 16 + swz / 64; C = (st & 1) * 32 + (swz % 64) / 2; }
__host__ __device__ __forceinline__ int perm32(int rho) { const int n = rho >> 4, i = rho & 15; return 8 * (i >> 2) + 4 * n + (i & 3); }
struct Unit { int pm, pn; };
struct Gemm { const bf16_t* A; const bf16_t* Bt; int K; unsigned lda_b; unsigned kstepA_b; unsigned ldb_b; };
struct StaticOrder {
    int nM, nN, nwg, G, c;
    __device__ void init(int M, int N, int G_, int c_) { nM = M / BM; nN = N / BM; nwg = nM * nN; G = G_; c = c_; }
    __device__ bool next(int i, Unit& u) const {
        const long L = (long)i * G + c; if (L >= nwg) return false;
        int wgid = (int)L; { const int q = nwg / NXCD, r = nwg % NXCD, xcd = wgid % NXCD, off = wgid / NXCD; wgid = (xcd < r ? xcd * (q + 1) : r * (q + 1) + (xcd - r) * q) + off; }
        const int nig = WGM * nN, gid = wgid / nig, fm = gid * WGM, gsz = (nM - fm) < WGM ? (nM - fm) : WGM;
        u.pm = fm + ((wgid % nig) % gsz); u.pn = (wgid % nig) / gsz; return true;
    }
};
struct OneUnit { int pm; __device__ bool next(int i, Unit& u) const { if (i) return false; u.pm = pm; u.pn = 0; return true; } };

template <class Epi, class Sched>
DI void gemm_phase(LAS unsigned char* lds, const Gemm g, const Sched& S, const Epi& E) {
    const int tid = otid(), wid = __builtin_amdgcn_readfirstlane(tid >> 6), lane = tid & 63, wr = wid >> 2, wc = wid & 3, fr = lane & 15, fq = lane >> 4;
    const int K = g.K, nt = K / BK; const unsigned ldb = g.ldb_b ? g.ldb_b : (unsigned)K * 2u;
    unsigned voffA[2], voffB[2];
#pragma unroll
    for (int i = 0; i < 2; ++i) { int R, C; stage_rc(tid * 16 + i * 8192, R, C); const int Rb = (R & ~31) + perm32(R & 31);
        voffA[i] = (unsigned)R * g.lda_b + (unsigned)C * 2u; voffB[i] = (unsigned)Rb * ldb + (unsigned)C * 2u; }
    const size_t kstepA = g.kstepA_b, kstepB = (size_t)(BK * 2);
    const size_t hstepA = (size_t)HALF * g.lda_b, hstepB = (size_t)HALF * ldb;
    const size_t tstepA = 2 * hstepA, tstepB = 2 * hstepB;
    const unsigned ldsw = (unsigned)wid * 1024u;
    const int aoff = lds_byte(wr * 64 + fr, fq * 8), boff = lds_byte(wc * 32 + fr, fq * 8);
#define PG8_SA(b, h) (((b) * 2 + (h)) * HTB)
#define PG8_SB(b, h) ((4 + (b) * 2 + (h)) * HTB)
#define PG8_STAGE(bufoff, gbase, voff) do { _Pragma("unroll") for (int _i = 0; _i < 2; ++_i) \
        __builtin_amdgcn_global_load_lds((const unsigned*)((const char*)(gbase) + (voff)[_i]), (LAS unsigned*)(lds + (bufoff) + ldsw + _i * 8192), 16, 0, 0); } while (0)
#define PG8_LDA(dst, b, h) do { _Pragma("unroll") for (int m = 0; m < 4; ++m) _Pragma("unroll") for (int k = 0; k < 2; ++k) dst[m][k] = *(const LAS bf16x8*)(lds + PG8_SA(b, h) + aoff + m * 2048 + k * 1024); } while (0)
#define PG8_LDB(dst, b, h) do { _Pragma("unroll") for (int n = 0; n < 2; ++n) _Pragma("unroll") for (int k = 0; k < 2; ++k) dst[n][k] = *(const LAS bf16x8*)(lds + PG8_SB(b, h) + boff + n * 2048 + k * 1024); } while (0)
#define PG8_MMA(ai, bj, At, Bt) do { __builtin_amdgcn_s_setprio(1); _Pragma("unroll") for (int m = 0; m < 4; ++m) _Pragma("unroll") for (int n = 0; n < 2; ++n) _Pragma("unroll") for (int k = 0; k < 2; ++k) \
        acc[ai][bj][m][n] = __builtin_amdgcn_mfma_f32_16x16x32_bf16(Bt[n][k], At[m][k], acc[ai][bj][m][n], 0, 0, 0); __builtin_amdgcn_s_setprio(0); } while (0)
#define PG8_WAIT_V(n) asm volatile("s_waitcnt vmcnt(" #n ")" ::: "memory")
#define PG8_WAIT_L(n) asm volatile("s_waitcnt lgkmcnt(" #n ")" ::: "memory")
#define PG8_BAR __builtin_amdgcn_s_barrier()
#define PG8_SCHED __builtin_amdgcn_sched_barrier(0)
    Unit cur, nxt; int ui = 0;
    if (!S.next(0, cur)) return;
    f32x4 acc[2][2][4][2];
#pragma unroll
    for (int a = 0; a < 2; ++a)
#pragma unroll
        for (int b = 0; b < 2; ++b)
#pragma unroll
            for (int m = 0; m < 4; ++m)
#pragma unroll
                for (int n = 0; n < 2; ++n) acc[a][b][m][n] = (f32x4){0.f, 0.f, 0.f, 0.f};
    bf16x8 At[4][2], B0[2][2], B1[2][2];
    const char* cA = (const char*)g.A + (size_t)cur.pm * tstepA; const char* cB = (const char*)g.Bt + (size_t)cur.pn * tstepB;
    PG8_STAGE(PG8_SB(0, 0), cB, voffB); PG8_STAGE(PG8_SB(0, 1), cB + hstepB, voffB); PG8_STAGE(PG8_SA(0, 0), cA, voffA); PG8_STAGE(PG8_SA(0, 1), cA + hstepA, voffA);
    if (wr == 1) PG8_BAR;
    PG8_WAIT_V(2); PG8_BAR;
    PG8_STAGE(PG8_SB(1, 0), cB + kstepB, voffB); PG8_STAGE(PG8_SA(1, 0), cA + kstepA, voffA); PG8_STAGE(PG8_SB(1, 1), cB + hstepB + kstepB, voffB);
    PG8_WAIT_V(6); PG8_BAR;
    for (;;) {
        const bool has_next = S.next(ui + 1, nxt);
        const char* nA = has_next ? (const char*)g.A + (size_t)nxt.pm * tstepA : cA; const char* nB = has_next ? (const char*)g.Bt + (size_t)nxt.pn * tstepB : cB;
        for (int t = 0; t < nt; t += 2) {
            const bool last = (t == nt - 2);
            const char* a1 = cA + (size_t)(t + 1) * kstepA;
            const char* a2 = last ? nA : cA + (size_t)(t + 2) * kstepA; const char* b2 = last ? nB : cB + (size_t)(t + 2) * kstepB;
            const char* a3 = a2 + kstepA; const char* b3 = b2 + kstepB;
            PG8_LDB(B0, 0, 0); PG8_LDB(B1, 0, 1); PG8_SCHED; PG8_LDA(At, 0, 0); PG8_STAGE(PG8_SA(1, 1), a1 + hstepA, voffA);
            PG8_WAIT_V(8); PG8_WAIT_L(0); PG8_BAR; PG8_MMA(0, 0, At, B0); PG8_MMA(0, 1, At, B1); PG8_BAR; PG8_SCHED;
            PG8_LDA(At, 0, 1); PG8_STAGE(PG8_SB(0, 0), b2, voffB); PG8_STAGE(PG8_SB(0, 1), b2 + hstepB, voffB); PG8_STAGE(PG8_SA(0, 0), a2, voffA);
            PG8_WAIT_V(8); PG8_WAIT_L(0); PG8_BAR; PG8_MMA(1, 0, At, B0); PG8_MMA(1, 1, At, B1); PG8_BAR; PG8_SCHED;
            PG8_LDB(B0, 1, 0); PG8_LDB(B1, 1, 1); PG8_SCHED; PG8_LDA(At, 1, 0); PG8_STAGE(PG8_SA(0, 1), a2 + hstepA, voffA);
            PG8_WAIT_V(8); PG8_WAIT_L(0); PG8_BAR; PG8_MMA(0, 0, At, B0); PG8_MMA(0, 1, At, B1); PG8_BAR; PG8_SCHED;
            PG8_LDA(At, 1, 1); PG8_STAGE(PG8_SB(1, 0), b3, voffB); PG8_STAGE(PG8_SB(1, 1), b3 + hstepB, voffB); PG8_STAGE(PG8_SA(1, 0), a3, voffA);
            PG8_WAIT_V(8); PG8_WAIT_L(0); PG8_BAR; PG8_MMA(1, 0, At, B0); PG8_MMA(1, 1, At, B1); PG8_BAR; PG8_SCHED;
        }
        if (wr == 0) PG8_BAR;
        E(acc, cur, wr, wc, fr, fq);
        if (!has_next) break;
#pragma unroll
        for (int a = 0; a < 2; ++a)
#pragma unroll
            for (int b = 0; b < 2; ++b)
#pragma unroll
                for (int m = 0; m < 4; ++m)
#pragma unroll
                    for (int n = 0; n < 2; ++n) acc[a][b][m][n] = (f32x4){0.f, 0.f, 0.f, 0.f};
        cur = nxt; cA = nA; cB = nB; ++ui;
        if (wr == 1) PG8_BAR;
    }
    PG8_WAIT_V(0);
    PG8_BAR;
#undef PG8_SA
#undef PG8_SB
#undef PG8_STAGE
#undef PG8_LDA
#undef PG8_LDB
#undef PG8_MMA
#undef PG8_WAIT_V
#undef PG8_WAIT_L
#undef PG8_BAR
#undef PG8_SCHED
}
}
using pg8::Unit;

DI float row_rinv(const float* ssq, int row, int fq) {
    const f32x4 sv = *(const f32x4*)(ssq + (size_t)row * 16 + 4 * fq);
    float s = (sv.x + sv.y) + (sv.z + sv.w); s += __shfl_xor(s, 16); s += __shfl_xor(s, 32);
    return rsqrtf(s * (1.0f / DM) + EPS);
}
DI void rows_rinv(const float* ssq, int row0, int fq, float (&rinv)[2][4]) {
    f32x4 sv[2][4];
#pragma unroll
    for (int ai = 0; ai < 2; ++ai)
#pragma unroll
        for (int m = 0; m < 4; ++m) sv[ai][m] = *(const f32x4*)(ssq + (size_t)(row0 + ai * 128 + m * 16) * 16 + 4 * fq);
#pragma unroll
    for (int ai = 0; ai < 2; ++ai)
#pragma unroll
        for (int m = 0; m < 4; ++m) { float t = (sv[ai][m].x + sv[ai][m].y) + (sv[ai][m].z + sv[ai][m].w); t += __shfl_xor(t, 16); t += __shfl_xor(t, 32); rinv[ai][m] = rsqrtf(t * (1.0f / DM) + EPS); }
}
struct EpiIn {
    bf16_t* Z; const float* ssq; const float* rope;
    DI void operator()(const f32x4 (&acc)[2][2][4][2], const Unit& u, int wr, int wc, int fr, int fq) const {
        const int pn = u.pn;
        int mode = 0; float scale = 1.f;
        if (pn < 2) { mode = 1; scale = QSCALE; }
        else if (pn == 3 || pn == 4) mode = (wc < 2) ? 1 : 0;
        else if (pn == 5) scale = (wc < 2) ? 0.17677669529663687f : 1.f;
        else if (pn == 8 || pn == 9) mode = 3;
        else if (pn == 10) mode = 4;
        const int lcol = pn * 256 + wc * 64 + 8 * fq;
        float rinvs[2][4]; rows_rinv(ssq, u.pm * 256 + wr * 64 + fr, fq, rinvs);
#pragma unroll
        for (int ai = 0; ai < 2; ++ai)
#pragma unroll
            for (int m = 0; m < 4; ++m) {
                const int row = u.pm * 256 + ai * 128 + wr * 64 + m * 16 + fr;
                const float rinv = rinvs[ai][m];
                f32x4 v00 = acc[ai][0][m][0] * rinv, v01 = acc[ai][0][m][1] * rinv, v10 = acc[ai][1][m][0] * rinv, v11 = acc[ai][1][m][1] * rinv;
                if (mode == 1) {
                    const float* rp = rope + (size_t)(row & (SEQ - 1)) * 64 + 8 * fq;
                    const f32x4 c0 = *(const f32x4*)rp, c1 = *(const f32x4*)(rp + 4), s0 = *(const f32x4*)(rp + 32), s1 = *(const f32x4*)(rp + 36);
                    const f32x4 a0 = v00 * c0 - v10 * s0, b0 = v10 * c0 + v00 * s0, a1 = v01 * c1 - v11 * s1, b1 = v11 * c1 + v01 * s1;
                    v00 = a0 * scale; v10 = b0 * scale; v01 = a1 * scale; v11 = b1 * scale;
                } else if (mode == 3) {
#pragma unroll
                    for (int e = 0; e < 4; ++e) { v00[e] = gelu_tanh(v00[e]); v01[e] = gelu_tanh(v01[e]); v10[e] = gelu_tanh(v10[e]); v11[e] = gelu_tanh(v11[e]); }
                } else if (mode == 4) {
                    if (wc == 0 && fq < 3) {
#pragma unroll
                        for (int e = 0; e < 4; ++e) { v00[e] = sigmoidf_(v00[e]); v01[e] = sigmoidf_(v01[e]); }
                    }
                } else { v00 = v00 * scale; v01 = v01 * scale; v10 = v10 * scale; v11 = v11 * scale; }
                bf16_t* zp = Z + (size_t)row * NZ + lcol;
                u32x4 w0, w1;
                w0.x = pk2(v00[0], v00[1]); w0.y = pk2(v00[2], v00[3]); w0.z = pk2(v01[0], v01[1]); w0.w = pk2(v01[2], v01[3]);
                w1.x = pk2(v10[0], v10[1]); w1.y = pk2(v10[2], v10[3]); w1.z = pk2(v11[0], v11[1]); w1.w = pk2(v11[2], v11[3]);
                *(u32x4*)zp = w0; *(u32x4*)(zp + 32) = w1;
            }
    }
};
struct EpiRes {
    bf16_t* XH; bf16_t* XL; float* ssq_out;
    DI void operator()(const f32x4 (&acc)[2][2][4][2], const Unit& u, int wr, int wc, int fr, int fq) const {
        const int col0 = u.pn * 256 + wc * 32 + 8 * fq;
#pragma unroll
        for (int ai = 0; ai < 2; ++ai) {
            u32x4 hv[4][2], lv[4][2];
#pragma unroll
            for (int m = 0; m < 4; ++m) { const size_t off = (size_t)(u.pm * 256 + ai * 128 + wr * 64 + m * 16 + fr) * DM + col0;
#pragma unroll
                for (int bj = 0; bj < 2; ++bj) { hv[m][bj] = *(const u32x4*)(XH + off + bj * 128); lv[m][bj] = *(const u32x4*)(XL + off + bj * 128); } }
#pragma unroll
            for (int m = 0; m < 4; ++m) {
                const int row = u.pm * 256 + ai * 128 + wr * 64 + m * 16 + fr; const size_t off = (size_t)row * DM + col0;
                float sq = 0.f;
#pragma unroll
                for (int bj = 0; bj < 2; ++bj) {
                    float x[8];
#pragma unroll
                    for (int e = 0; e < 4; ++e) { x[2 * e] = (bflo(hv[m][bj][e]) + bflo(lv[m][bj][e])) + acc[ai][bj][m][e >> 1][(2 * e) & 3]; x[2 * e + 1] = (bfhi(hv[m][bj][e]) + bfhi(lv[m][bj][e])) + acc[ai][bj][m][e >> 1][(2 * e + 1) & 3]; }
                    u32x4 wh, wl;
#pragma unroll
                    for (int e = 0; e < 4; ++e) { wh[e] = pk2(x[2 * e], x[2 * e + 1]); wl[e] = pk2(x[2 * e] - bflo(wh[e]), x[2 * e + 1] - bfhi(wh[e])); sq += x[2 * e] * x[2 * e] + x[2 * e + 1] * x[2 * e + 1]; }
                    *(u32x4*)(XH + off + bj * 128) = wh; *(u32x4*)(XL + off + bj * 128) = wl;
                }
                sq += __shfl_xor(sq, 16); sq += __shfl_xor(sq, 32);
                if (fq == 0) ssq_out[(size_t)row * 16 + u.pn * 4 + wc] = sq;
            }
        }
    }
};
struct EpiGlu {
    bf16_t* H; const float* ssq;
    DI void operator()(const f32x4 (&acc)[2][2][4][2], const Unit& u, int wr, int wc, int fr, int fq) const {
        const int col0 = u.pn * 128 + wc * 32 + 8 * fq;
        float rinvs[2][4]; rows_rinv(ssq, u.pm * 256 + wr * 64 + fr, fq, rinvs);
#pragma unroll
        for (int ai = 0; ai < 2; ++ai)
#pragma unroll
            for (int m = 0; m < 4; ++m) {
                const int row = u.pm * 256 + ai * 128 + wr * 64 + m * 16 + fr;
                const float rinv = rinvs[ai][m];
                float o[8];
#pragma unroll
                for (int n = 0; n < 2; ++n)
#pragma unroll
                    for (int e = 0; e < 4; ++e) { const float gt = acc[ai][0][m][n][e] * rinv, up = acc[ai][1][m][n][e] * rinv; o[n * 4 + e] = siluf_(gt) * up; }
                u32x4 w; w.x = pk2(o[0], o[1]); w.y = pk2(o[2], o[3]); w.z = pk2(o[4], o[5]); w.w = pk2(o[6], o[7]);
                *(u32x4*)(H + (size_t)row * DFF + col0) = w;
            }
    }
};
struct EpiCmp {
    bf16_t* CH; const float* bias;
    DI void operator()(const f32x4 (&acc)[2][2][4][2], const Unit& u, int wr, int wc, int fr, int fq) const {
        const int col0 = wc * 32 + 8 * fq;
#pragma unroll
        for (int ai = 0; ai < 2; ++ai)
#pragma unroll
            for (int m = 0; m < 4; ++m) {
                const int row = u.pm * 256 + ai * 128 + wr * 64 + m * 16 + fr;
#pragma unroll
                for (int bj = 0; bj < 2; ++bj) {
                    const f32x4 b0 = *(const f32x4*)(bias + col0 + bj * 128), b1 = *(const f32x4*)(bias + col0 + bj * 128 + 4);
                    const f32x4 v0 = acc[ai][bj][m][0] + b0, v1 = acc[ai][bj][m][1] + b1;
                    u32x4 w; w.x = pk2(gelu_tanh(v0[0]), gelu_tanh(v0[1])); w.y = pk2(gelu_tanh(v0[2]), gelu_tanh(v0[3])); w.z = pk2(gelu_tanh(v1[0]), gelu_tanh(v1[1])); w.w = pk2(gelu_tanh(v1[2]), gelu_tanh(v1[3]));
                    *(u32x4*)(CH + (size_t)row * 256 + col0 + bj * 128) = w;
                }
            }
    }
};

DI int srccol(int zc) {
    if (zc < 1280) return zc;
    if (zc < 1792) return zc + 24;
    if (zc < 2560) return zc + 40;
    if (zc < 2584) return 1280 + (zc - 2560);
    if (zc >= 2592 && zc < 2608) return 1816 + (zc - 2592);
    return -1;
}
struct FIn { const float* w; const float* g; DI float operator()(int k, int n) const {
    const int tile = n >> 8, loc = n & 255, bj = loc >> 7, wc = (loc >> 5) & 3, x = loc & 31; const int sc = srccol(tile * 256 + wc * 64 + bj * 32 + x);
    return sc < 0 ? 0.f : w[(size_t)k * DIN + sc] * g[k]; } };
struct FPlain { const float* w; int ldw; DI float operator()(int k, int n) const { return w[(size_t)k * ldw + n]; } };
struct FGu { const float* wg; const float* wu; const float* g; DI float operator()(int k, int n) const {
    const int tile = n >> 8, loc = n & 255, bj = loc >> 7, col = tile * 128 + (loc & 127); const float* base = (const float*)((uintptr_t)wg + (bj ? (uintptr_t)wu - (uintptr_t)wg : (uintptr_t)0)); return base[(size_t)k * DFF + col] * g[k]; } };
template <class F> DI void tr_item(const F& f, int pitch, bf16_t* WT, float* scr, int kb, int nb, int lane) {
    const int k0 = 64 * kb, n0 = 32 * nb;
#pragma unroll 8
    for (int i = 0; i < 32; ++i) { const int kk = 2 * i + (lane >> 5); scr[kk * 33 + (lane & 31)] = f(k0 + kk, n0 + (lane & 31)); }
    __builtin_amdgcn_s_waitcnt(0xc07f); asm volatile("" ::: "memory");
    const int c = lane & 7;
#pragma unroll
    for (int j = 0; j < 4; ++j) { const int n = (lane >> 3) + 8 * j; const float* s = scr + (8 * c) * 33 + n;
        u32x4 o; o.x = pk2(s[0 * 33], s[1 * 33]); o.y = pk2(s[2 * 33], s[3 * 33]); o.z = pk2(s[4 * 33], s[5 * 33]); o.w = pk2(s[6 * 33], s[7 * 33]);
        *(u32x4*)(WT + (size_t)(n0 + n) * pitch + k0 + 8 * c) = o; }
    __builtin_amdgcn_s_waitcnt(0xc07f); asm volatile("" ::: "memory");
}
DI void phase0(const Params& p, unsigned char* lds) {
    const int tid = otid(), lane = tid & 63, wave = tid >> 6;
    const int gw = blockIdx.x * 8 + wave, NGW = gridDim.x * 8;
    float* scr = (float*)lds + wave * (64 * 33);
    unsigned char* ws = p.ws;
    constexpr int I_IN = 16 * 88, I_OUT = 16 * 32, I_GU = 16 * 176, I_DN = 44 * 32, I_C = 32 * 8, I_L = I_IN + I_OUT + I_GU + I_DN + 2 * I_C;
    for (int it = gw; it < NL * I_L; it += NGW) {
        const int l = it / I_L; int r = it % I_L;
        if (r < I_IN) { FIn f{p.in[2] + (size_t)l * DM * DIN, p.in[1] + l * DM}; tr_item(f, WP, (bf16_t*)(ws + WS_WIN) + (size_t)l * NZ * WP, scr, r / 88, r % 88, lane); continue; } r -= I_IN;
        if (r < I_OUT) { FPlain f{p.in[16] + (size_t)l * DM * DM, DM}; tr_item(f, WP, (bf16_t*)(ws + WS_WOUT) + (size_t)l * DM * WP, scr, r / 32, r % 32, lane); continue; } r -= I_OUT;
        if (r < I_GU) { FGu f{p.in[18] + (size_t)l * DM * DFF, p.in[19] + (size_t)l * DM * DFF, p.in[17] + l * DM}; tr_item(f, WP, (bf16_t*)(ws + WS_WGU) + (size_t)l * 2 * DFF * WP, scr, r / 176, r % 176, lane); continue; } r -= I_GU;
        if (r < I_DN) { FPlain f{p.in[20] + (size_t)l * DFF * DM, DM}; tr_item(f, DFF, (bf16_t*)(ws + WS_WDN) + (size_t)l * DM * DFF, scr, r / 32, r % 32, lane); continue; } r -= I_DN;
        const int kv = r / I_C; r %= I_C;
        FPlain f{(kv ? p.in[7] : p.in[4]) + (size_t)l * 2048 * 256, 256}; tr_item(f, WPC, (bf16_t*)(ws + WS_WC1) + (size_t)(l * 2 + kv) * 256 * WPC, scr, r / 8, r % 8, lane);
    }
    {
        const float* x = p.in[0]; bf16_t* XH = (bf16_t*)(ws + WS_XB); bf16_t* XLo = (bf16_t*)(ws + WS_XL); float* ssq = (float*)(ws + WS_SSQA);
        for (int m = gw; m < MTOK; m += NGW) {
            const f32x4* xr = (const f32x4*)(x + (size_t)m * DM) + lane; u32x2* ho = (u32x2*)(XH + (size_t)m * DM) + lane; u32x2* lo = (u32x2*)(XLo + (size_t)m * DM) + lane;
            float s = 0.f;
#pragma unroll
            for (int j = 0; j < 4; ++j) { const f32x4 v = xr[64 * j]; u32x2 wh, wl; wh.x = pk2(v.x, v.y); wh.y = pk2(v.z, v.w);
                wl.x = pk2(v.x - bflo(wh.x), v.y - bfhi(wh.x)); wl.y = pk2(v.z - bflo(wh.y), v.w - bfhi(wh.y)); ho[64 * j] = wh; lo[64 * j] = wl; s += (v.x * v.x + v.y * v.y) + (v.z * v.z + v.w * v.w); }
            s = wave_sum(s);
            if (lane < 16) ssq[(size_t)m * 16 + lane] = lane == 0 ? s : 0.f;
        }
    }
    const int gt = blockIdx.x * 512 + tid, NGT = gridDim.x * 512;
    { float* rope = (float*)(ws + WS_ROPE);
      for (int i = gt; i < SEQ * 32; i += NGT) { const int pos = i >> 5, j = i & 31; const float inv = __builtin_amdgcn_exp2f(-(float)j * (13.287712379549449f / 32.0f)); const float ang = (float)pos * inv; double rev = (double)ang * 0.15915494309189535; rev -= __builtin_floor(rev); const float rf = (float)rev; const float sn = __builtin_amdgcn_sinf(rf), cs = __builtin_amdgcn_cosf(rf); rope[pos * 64 + j] = cs; rope[pos * 64 + 32 + j] = sn; } }
    { float* posb = (float*)(ws + WS_POSB); float* red = (float*)lds + 8 * 64 * 33;
      for (int job = blockIdx.x; job < NL * 2 * 8; job += gridDim.x) { const int nc = job & 7, kv = (job >> 3) & 1, l = job >> 4, nl = tid & 31, ks = tid >> 5;
          const float* pe = (kv ? p.in[6] : p.in[3]) + (size_t)l * 2048 + ks * 128; const float* w1 = (kv ? p.in[7] : p.in[4]) + (size_t)l * 2048 * 256 + (size_t)ks * 128 * 256 + nc * 32 + nl;
          float s0 = 0.f, s1 = 0.f, s2 = 0.f, s3 = 0.f;
#pragma unroll 4
          for (int k = 0; k < 128; k += 4) { s0 += pe[k] * w1[(size_t)k * 256]; s1 += pe[k + 1] * w1[(size_t)(k + 1) * 256]; s2 += pe[k + 2] * w1[(size_t)(k + 2) * 256]; s3 += pe[k + 3] * w1[(size_t)(k + 3) * 256]; }
          red[ks * 32 + nl] = (s0 + s1) + (s2 + s3);
          __syncthreads();
          if (tid < 32) { float t = 0.f; for (int q = 0; q < 16; ++q) t += red[q * 32 + tid]; posb[(l * 2 + kv) * 256 + nc * 32 + tid] = t; }
          __syncthreads(); } }
    { bf16_t* w2t = (bf16_t*)(ws + WS_W2T);
      for (int i = gt; i < NL * 2 * 64 * 256; i += NGT) { const int k = i & 255, d = (i >> 8) & 63, kv = (i >> 14) & 1, l = i >> 15; w2t[i] = (bf16_t)f2bf((kv ? p.in[8] : p.in[5])[(size_t)l * 256 * 64 + k * 64 + d]); } }
    { bf16_t* sgw = (bf16_t*)(ws + WS_SGW); const float* w = p.in[14];
      for (int i = gt; i < NL * 4 * 128 * 128; i += NGT) { const int j = i & 127, ii = (i >> 7) & 127; sgw[i] = (bf16_t)f2bf(j <= ii ? w[i] : 0.f); } }
}

DI void compress2(const Params& p, int l, int set, int pm) {
    const int tid = otid(), lane = tid & 63, w = tid >> 6, r32 = lane & 31, hi = lane >> 5;
    const int kv = set >> 1, g = set & 1, rbase = pm * 256 + w * 32;
    const bf16_t* A = (const bf16_t*)(p.ws + WS_CH) + ((size_t)set * 2048 + rbase + r32) * 256 + 8 * hi;
    const bf16_t* Bt = (const bf16_t*)(p.ws + WS_W2T) + (size_t)(l * 2 + kv) * 64 * 256 + (size_t)r32 * 256 + 8 * hi;
    f32x16 a0 = {}, a1 = {};
#pragma unroll 4
    for (int k0 = 0; k0 < 256; k0 += 16) { const bf16x8 av = *(const bf16x8*)(A + k0), b0 = *(const bf16x8*)(Bt + k0), b1 = *(const bf16x8*)(Bt + 32 * 256 + k0); a0 = MFMA32(av, b0, a0); a1 = MFMA32(av, b1, a1); }
    const float* rope = (const float*)(p.ws + WS_ROPE);
    bf16_t* obase = (bf16_t*)(p.ws + (kv ? WS_VC : WS_KC));
#pragma unroll
    for (int r = 0; r < 16; ++r) { const int row = rbase + crow(r, hi), c = row & 255, b = row >> 8;
        float v0 = a0[r], v1 = a1[r];
        if (kv == 0) { const float* rp = rope + (size_t)(16 * c + 31) * 64 + r32; const float cs = rp[0], sn = rp[32]; const float t0 = v0 * cs - v1 * sn, t1 = v1 * cs + v0 * sn; v0 = t0; v1 = t1; }
        if (c != 255) { bf16_t* o = obase + ((size_t)(b * 2 + g) * 256 + c) * 64 + r32; o[0] = (bf16_t)f2bf(v0); o[32] = (bf16_t)f2bf(v1); } }
}

DI f32x16 mm32(const bf16_t* A, int lda, const bf16_t* Bt, int ldb, int K, f32x16 acc, int r32, int hi) {
    for (int k0 = 0; k0 < K; k0 += 16) { const bf16x8 a = *(const bf16x8*)(A + r32 * lda + k0 + 8 * hi), b = *(const bf16x8*)(Bt + r32 * ldb + k0 + 8 * hi); acc = MFMA32(a, b, acc); }
    return acc;
}

DI void gla_vT_sts(const u32x4 v, int j, int vq, bf16_t* vT) {
#pragma unroll
    for (int e = 0; e < 4; ++e) { vT[(vq + 2 * e) * 72 + j] = (bf16_t)(v[e] & 0xffffu); vT[(vq + 2 * e + 1) * 72 + j] = (bf16_t)(v[e] >> 16); }
}
DI void gla_g1_pair(const Params& p, int l, int item0, int limit, unsigned char* lds) {
    const int tid = otid(), half = tid >> 8, t = tid & 255, lane = tid & 63, wl = (tid >> 6) & 3, r32 = lane & 31, hi = lane >> 5;
    const int item = item0 + half; const bool live = item < limit;
    const int n = item & 63, h = (item >> 6) & 3, b = item >> 8; const int T0 = b * SEQ + n * 64;
    const bf16_t* Z = (const bf16_t*)(p.ws + WS_Z);
    unsigned char* lb = lds + half * 22528;
    float* bc = (float*)lb; bf16_t* vT = (bf16_t*)(lb + 8448); bf16_t* kdT = (bf16_t*)(lb + 17664);
    const int j = t >> 2, kq = (t & 3) * 8, vq = (t & 3) * 16;
    u32x4 a0 = {}, a1 = {}, kk = {}, v0 = {}, v1 = {};
    if (live) { const bf16_t* zr = Z + (size_t)(T0 + j) * NZ;
        a0 = *(const u32x4*)(zr + ZGA); a1 = *(const u32x4*)(zr + ZGA + 8);
        kk = *(const u32x4*)(zr + ZGK + h * 32 + kq);
        v0 = *(const u32x4*)(zr + ZGV + h * 64 + vq); v1 = *(const u32x4*)(zr + ZGV + h * 64 + vq + 8); }
    if (live) {
        const float* wup = p.in[9] + (size_t)l * 16 * 128 + h * 32 + kq;
        f32x4 x0 = *(const f32x4*)(p.in[10] + l * 128 + h * 32 + kq), x1 = *(const f32x4*)(p.in[10] + l * 128 + h * 32 + kq + 4);
        float a[16];
#pragma unroll
        for (int e = 0; e < 4; ++e) { a[2 * e] = bflo(a0[e]); a[2 * e + 1] = bfhi(a0[e]); a[8 + 2 * e] = bflo(a1[e]); a[8 + 2 * e + 1] = bfhi(a1[e]); }
#pragma unroll
        for (int r = 0; r < 16; ++r) { x0 += *(const f32x4*)(wup + r * 128) * a[r]; x1 += *(const f32x4*)(wup + r * 128 + 4) * a[r]; }
#pragma unroll
        for (int e = 0; e < 4; ++e) { bc[j * 33 + kq + e] = (fminf(x0[e], 0.f) - __logf(1.0f + __expf(-fabsf(x0[e])))) * (1.0f / 16.0f);
                                      bc[j * 33 + kq + 4 + e] = (fminf(x1[e], 0.f) - __logf(1.0f + __expf(-fabsf(x1[e])))) * (1.0f / 16.0f); }
#pragma unroll
        for (int e = 0; e < 4; ++e) { vT[(vq + 2 * e) * 72 + j] = (bf16_t)(v0[e] & 0xffffu); vT[(vq + 2 * e + 1) * 72 + j] = (bf16_t)(v0[e] >> 16);
                                      vT[(vq + 8 + 2 * e) * 72 + j] = (bf16_t)(v1[e] & 0xffffu); vT[(vq + 8 + 2 * e + 1) * 72 + j] = (bf16_t)(v1[e] >> 16); }
    }
    __syncthreads();
    if (live) { float v[8];
#pragma unroll
        for (int e = 0; e < 8; ++e) v[e] = bc[lane * 33 + 8 * wl + e];
#pragma unroll
        for (int d = 1; d < 64; d <<= 1) {
#pragma unroll
            for (int e = 0; e < 8; ++e) { const float tt = __shfl_up(v[e], d); if (lane >= d) v[e] += tt; } }
#pragma unroll
        for (int e = 0; e < 8; ++e) bc[lane * 33 + 8 * wl + e] = v[e]; }
    __syncthreads();
    if (live) { const float* bp = bc + j * 33 + kq; float bv[8];
#pragma unroll
        for (int e = 0; e < 8; ++e) bv[e] = bp[e];
        float* bo = p.out + (size_t)item * 2048 + j * 32 + kq;
        *(f32x4*)bo = (f32x4){bv[0], bv[1], bv[2], bv[3]}; *(f32x4*)(bo + 4) = (f32x4){bv[4], bv[5], bv[6], bv[7]};
#pragma unroll
        for (int e = 0; e < 4; ++e) { kdT[(kq + 2 * e) * 72 + j] = (bf16_t)f2bf(bflo(kk[e]) * __expf(bc[63 * 33 + kq + 2 * e] - bv[2 * e]));
                                      kdT[(kq + 2 * e + 1) * 72 + j] = (bf16_t)f2bf(bfhi(kk[e]) * __expf(bc[63 * 33 + kq + 2 * e + 1] - bv[2 * e + 1])); } }
    __syncthreads();
    if (live) { float* gds = (float*)(p.ws + WS_GDS) + (size_t)item * 2048;
        if (wl < 2) { f32x16 acc = {}; acc = mm32(vT + wl * 32 * 72, 72, kdT, 72, 64, acc, r32, hi);
#pragma unroll
            for (int r = 0; r < 16; ++r) gds[(32 * wl + crow(r, hi)) * 32 + r32] = acc[r]; }
        if (t < 32) ((float*)(p.ws + WS_GDEC))[(size_t)item * 32 + t] = __expf(bc[63 * 33 + t]); }
    __syncthreads();
}
DI void gla_g2(const Params& p, int gt) {
    const int seq = gt >> 11, e = gt & 2047, k = e & 31;
    float* gds = (float*)(p.ws + WS_GDS) + (size_t)seq * 64 * 2048 + e; const float* dec = (const float*)(p.ws + WS_GDEC) + (size_t)seq * 64 * 32 + k;
    float s = 0.f;
#pragma unroll 32
    for (int n = 0; n < 64; ++n) { const float d = gds[(size_t)n * 2048], dc = dec[n * 32]; gds[(size_t)n * 2048] = s; s = dc * s + d; }
}
struct G3Regs { f32x4 bv, sv; u32x2 qq, kk; u32x4 vv; };
DI G3Regs gla_g3_load(const Params& p, int item, int tid) {
    const int n = item & 63, h = (item >> 6) & 3, b = item >> 8; const int T0 = b * SEQ + n * 64;
    const int i = tid >> 3, kq = (tid & 7) * 4, vq = (tid & 7) * 8;
    const bf16_t* zr = (const bf16_t*)(p.ws + WS_Z) + (size_t)(T0 + i) * NZ; G3Regs R;
    R.bv = *(const f32x4*)(p.out + (size_t)item * 2048 + i * 32 + kq);
    R.qq = *(const u32x2*)(zr + ZGQ + h * 32 + kq); R.kk = *(const u32x2*)(zr + ZGK + h * 32 + kq);
    R.sv = *(const f32x4*)((const float*)(p.ws + WS_GDS) + (size_t)item * 2048 + i * 32 + kq);
    R.vv = *(const u32x4*)(zr + ZGV + h * 64 + vq);
    return R;
}
DI void gla_g3(const Params& p, int l, int item, unsigned char* lds, int tid, const G3Regs R) {
    const int lane = tid & 63, w = tid >> 6, r32 = lane & 31, hi = lane >> 5;
    const int n = item & 63, h = (item >> 6) & 3, b = item >> 8; const int T0 = b * SEQ + n * 64;
    const bf16_t* Z = (const bf16_t*)(p.ws + WS_Z);
    bf16_t* qe = (bf16_t*)(lds + 8448); bf16_t* kt = (bf16_t*)(lds + 13568); bf16_t* St = (bf16_t*)(lds + 18688); bf16_t* vT = (bf16_t*)(lds + 23808); bf16_t* at = (bf16_t*)(lds + 33024);
    const int i = tid >> 3, kq = (tid & 7) * 4, vq = (tid & 7) * 8;
    const f32x4 bv = R.bv, sv = R.sv; const u32x2 qq = R.qq, kk = R.kk; const u32x4 vv = R.vv;
    u32x2 rr[2][4]; f32x4 gvv[2][4];
    if (w < 2) { const bf16_t* rz = Z + (size_t)(T0 + 32 * w + r32) * NZ + ZGR + h * 64; const float* gn = p.in[11] + l * 64;
#pragma unroll
        for (int vb = 0; vb < 2; ++vb)
#pragma unroll
            for (int a4 = 0; a4 < 4; ++a4) { const int v0 = 32 * vb + 8 * a4 + 4 * hi; rr[vb][a4] = *(const u32x2*)(rz + v0); gvv[vb][a4] = *(const f32x4*)(gn + v0); } }
    { const float qf[4] = {bflo(qq.x), bfhi(qq.x), bflo(qq.y), bfhi(qq.y)}, kf[4] = {bflo(kk.x), bfhi(kk.x), bflo(kk.y), bfhi(kk.y)};
#pragma unroll
      for (int e = 0; e < 4; ++e) { const float eb = __expf(bv[e]); qe[i * 40 + kq + e] = (bf16_t)f2bf(qf[e] * eb); kt[i * 40 + kq + e] = (bf16_t)f2bf(kf[e] * __expf(-bv[e])); St[i * 40 + kq + e] = (bf16_t)f2bf(sv[e]); } }
    gla_vT_sts(vv, i, vq, vT);
    __syncthreads();
    if (w < 4) { const int jb = w >> 1, ib = w & 1; f32x16 acc = {}; acc = mm32(kt + jb * 32 * 40, 40, qe + ib * 32 * 40, 40, 32, acc, r32, hi);
        const int ii = 32 * ib + r32;
#pragma unroll
        for (int a4 = 0; a4 < 4; ++a4) { const int j0 = 32 * jb + 8 * a4 + 4 * hi; float v[4];
#pragma unroll
            for (int e = 0; e < 4; ++e) v[e] = (j0 + e <= ii) ? acc[4 * a4 + e] : 0.f;
            u32x2 wv; wv.x = pk2(v[0], v[1]); wv.y = pk2(v[2], v[3]); *(u32x2*)(at + ii * 72 + j0) = wv; } }
    __syncthreads();
    if (w < 2) { const int ib = w, ii = 32 * ib + r32; f32x16 o[2];
#pragma unroll
        for (int vb = 0; vb < 2; ++vb) { o[vb] = (f32x16){}; o[vb] = mm32(St + vb * 32 * 40, 40, qe + ib * 32 * 40, 40, 32, o[vb], r32, hi); o[vb] = mm32(vT + vb * 32 * 72, 72, at + ib * 32 * 72, 72, 64, o[vb], r32, hi); }
        float ss = 0.f;
#pragma unroll
        for (int r = 0; r < 16; ++r) ss += o[0][r] * o[0][r] + o[1][r] * o[1][r];
        ss += __shfl_xor(ss, 32);
        const float rn = rsqrtf(ss * (1.0f / 64.0f) + EPS);
        bf16_t* mix = (bf16_t*)(p.ws + WS_MIX) + (size_t)(T0 + ii) * DM + 512 + h * 64;
#pragma unroll
        for (int vb = 0; vb < 2; ++vb)
#pragma unroll
            for (int a4 = 0; a4 < 4; ++a4) { const int v0 = 32 * vb + 8 * a4 + 4 * hi; const u32x2 rw = rr[vb][a4]; const f32x4 gv = gvv[vb][a4];
                const float rf[4] = {bflo(rw.x), bfhi(rw.x), bflo(rw.y), bfhi(rw.y)}; float ov[4];
#pragma unroll
                for (int e = 0; e < 4; ++e) ov[e] = o[vb][4 * a4 + e] * rn * gv[e] * siluf_(rf[e]);
                u32x2 wv; wv.x = pk2(ov[0], ov[1]); wv.y = pk2(ov[2], ov[3]); *(u32x2*)(mix + v0) = wv; } }
    __syncthreads();
}

DI void sg_item(const Params& p, int l, int item, unsigned char* lds) {
    const int tid = otid(), lane = tid & 63, w = tid >> 6, r32 = lane & 31, hi = lane >> 5;
    const int T0 = item * 128; const bf16_t* Z = (const bf16_t*)(p.ws + WS_Z); bf16_t* vT = (bf16_t*)lds;
    const int g2 = w >> 1, cb = w & 1;
    const bf16_t* sgw = (const bf16_t*)(p.ws + WS_SGW) + (size_t)(l * 4 + g2) * 128 * 128; const float* sgb = p.in[15] + (size_t)(l * 4 + g2) * 128;
    bf16x8 bfr[20]; u32x2 uu[4][4]; float bias[4];
#pragma unroll
    for (int ib = 0; ib < 4; ++ib) {
#pragma unroll
        for (int ks = 0; ks < 2 * (ib + 1); ++ks) bfr[ib * (ib + 1) + ks] = *(const bf16x8*)(sgw + (size_t)(ib * 32 + r32) * 128 + 16 * ks + 8 * hi);
        bias[ib] = sgb[ib * 32 + r32];
#pragma unroll
        for (int a4 = 0; a4 < 4; ++a4) uu[ib][a4] = *(const u32x2*)(Z + (size_t)(T0 + ib * 32 + r32) * NZ + ZUV + g2 * 64 + 32 * cb + 8 * a4 + 4 * hi);
    }
    { const int tok = tid >> 2, g = tid & 3; const bf16_t* vp = Z + (size_t)(T0 + tok) * NZ + ZUV + 256 + g * 64;
      float v[64];
#pragma unroll
      for (int c8 = 0; c8 < 8; ++c8) { const u32x4 x = *(const u32x4*)(vp + 8 * c8);
#pragma unroll
          for (int e = 0; e < 4; ++e) { v[8 * c8 + 2 * e] = bflo(x[e]); v[8 * c8 + 2 * e + 1] = bfhi(x[e]); } }
      float sm = 0.f;
#pragma unroll
      for (int c = 0; c < 64; ++c) sm += v[c];
      sm += __shfl_xor(sm, 1); sm += __shfl_xor(sm, 2);
      const float mu = sm * (1.0f / 256.0f); float q = 0.f;
#pragma unroll
      for (int c = 0; c < 64; ++c) { const float d = v[c] - mu; q += d * d; }
      q += __shfl_xor(q, 1); q += __shfl_xor(q, 2);
      const float rstd = rsqrtf(q * (1.0f / 256.0f) + EPS);
      const float* lg = p.in[12] + l * 256 + g * 64; const float* lb = p.in[13] + l * 256 + g * 64;
#pragma unroll
      for (int c = 0; c < 64; ++c) vT[(g * 64 + c) * 136 + tok] = (bf16_t)f2bf((v[c] - mu) * rstd * lg[c] + lb[c]); }
    __syncthreads();
    { bf16_t* mix = (bf16_t*)(p.ws + WS_MIX);
#pragma unroll
      for (int ib = 0; ib < 4; ++ib) { f32x16 acc = {};
#pragma unroll
          for (int ks = 0; ks < 2 * (ib + 1); ++ks) { const bf16x8 a = *(const bf16x8*)(vT + (g2 * 64 + cb * 32 + r32) * 136 + 16 * ks + 8 * hi); acc = MFMA32(a, bfr[ib * (ib + 1) + ks], acc); }
          const int i = ib * 32 + r32;
#pragma unroll
          for (int a4 = 0; a4 < 4; ++a4) { const int c0 = 32 * cb + 8 * a4 + 4 * hi; const u32x2 u2 = uu[ib][a4];
              const float uf[4] = {bflo(u2.x), bfhi(u2.x), bflo(u2.y), bfhi(u2.y)}; float ov[4];
#pragma unroll
              for (int e = 0; e < 4; ++e) ov[e] = uf[e] * (acc[4 * a4 + e] + bias[ib]);
              u32x2 wv; wv.x = pk2(ov[0], ov[1]); wv.y = pk2(ov[2], ov[3]); *(u32x2*)(mix + (size_t)(T0 + i) * DM + 768 + g2 * 64 + c0) = wv; } } }
    __syncthreads();
}

struct TileRegs { u32x4 a, b; };
DI TileRegs tile_gload_(int tid, const bf16_t* kbase, const bf16_t* vbase, int stride) {
    const int w = tid >> 6, lane = tid & 63; TileRegs t;
    if (w < 4) { const int rp = lane & 31, ch = 2 * w + (lane >> 5); const bf16_t* vp = vbase + (size_t)(2 * rp) * stride + ch * 8; t.a = *(const u32x4*)vp; t.b = *(const u32x4*)(vp + stride); }
    else { const int id = tid - 256; t.a = *(const u32x4*)(kbase + (size_t)(id >> 3) * stride + (id & 7) * 8); t.b = *(const u32x4*)(kbase + (size_t)((id >> 3) + 32) * stride + (id & 7) * 8); }
    return t;
}
DI void tile_sts_(int tid, const TileRegs& t, bf16_t* Ks, bf16_t* Vt) {
    const int w = tid >> 6, lane = tid & 63;
    if (w < 4) { const int rp = lane & 31, ch = 2 * w + (lane >> 5); unsigned* vd = (unsigned*)Vt + (ch * 8) * 34 + rp;
#pragma unroll
        for (int e = 0; e < 4; ++e) { vd[(2 * e) * 34] = (t.a[e] & 0xffffu) | (t.b[e] << 16); vd[(2 * e + 1) * 34] = (t.a[e] >> 16) | (t.b[e] & 0xffff0000u); } }
    else { const int id = tid - 256; *(u32x4*)(Ks + (id >> 3) * 72 + (id & 7) * 8) = t.a; *(u32x4*)(Ks + ((id >> 3) + 32) * 72 + (id & 7) * 8) = t.b; }
}
DI void attn_S(const bf16_t* Kb, const bf16x8 (&qr)[4], const f32x16& negm, f32x16& p0, f32x16& p1, int r32, int hi) {
#pragma unroll
    for (int d0 = 0; d0 < 4; ++d0) { const bf16x8 a0 = *(const bf16x8*)(Kb + r32 * 72 + d0 * 16 + hi * 8), a1 = *(const bf16x8*)(Kb + (32 + r32) * 72 + d0 * 16 + hi * 8);
        if (d0 == 0) { p0 = MFMA32(a0, qr[0], negm); p1 = MFMA32(a1, qr[0], negm); } else { p0 = MFMA32(a0, qr[d0], p0); p1 = MFMA32(a1, qr[d0], p1); } }
}
DI void attn_PV(const bf16_t* Vb, const f32x16& p0, const f32x16& p1, f32x16 (&o)[2], int r32, int hi, unsigned lmask) {
#pragma unroll
    for (int hf = 0; hf < 2; ++hf)
#pragma unroll
        for (int s = 0; s < 2; ++s) {
            u32x4 pw;
#pragma unroll
            for (int e = 0; e < 4; ++e) pw[e] = (hf ? pk2(p1[8 * s + 2 * e], p1[8 * s + 2 * e + 1]) : pk2(p0[8 * s + 2 * e], p0[8 * s + 2 * e + 1])) & lmask;
            const bf16x8 pb = __builtin_bit_cast(bf16x8, pw);
#pragma unroll
            for (int db = 0; db < 2; ++db) { const bf16_t* vp = Vb + (r32 + 32 * db) * 68 + 32 * hf + 16 * s + 4 * hi;
                const s16x4 lo = *(const s16x4*)vp, hh = *(const s16x4*)(vp + 8);
                const bf16x8 va = __builtin_shufflevector(lo, hh, 0, 1, 2, 3, 4, 5, 6, 7);
                o[db] = MFMA32(va, pb, o[db]); }
        }
}
DI float rowmax32(const f32x16& p0, const f32x16& p1) {
    float a = fmaxf(fmaxf(p0[0], p0[1]), p1[0]), b = fmaxf(fmaxf(p0[2], p0[3]), p1[1]); a = fmaxf(fmaxf(a, p1[2]), p1[3]);
#pragma unroll
    for (int r = 4; r < 16; r += 4) { a = fmaxf(fmaxf(a, p0[r]), p0[r + 1]); b = fmaxf(fmaxf(b, p0[r + 2]), p0[r + 3]); a = fmaxf(fmaxf(a, p1[r]), p1[r + 1]); b = fmaxf(fmaxf(b, p1[r + 2]), p1[r + 3]); }
    const float mx = fmaxf(a, b);
    return fmaxf(mx, __shfl_xor(mx, 32));
}
template <bool WITH_O>
DI void attn_softmax(f32x16& p0, f32x16& p1, float& m, float& lsum, f32x16 (&o)[2], f32x16& negm, bool on) {
    float mx = rowmax32(p0, p1);
    if (!on) mx = -INFINITY;
    if (__any(mx > 8.0f)) {
        const float dl = fmaxf(mx, 0.f), al = __builtin_amdgcn_exp2f(-dl);
        m += dl; lsum *= al;
#pragma unroll
        for (int r = 0; r < 16; ++r) { p0[r] -= dl; p1[r] -= dl; negm[r] = -m; }
        if (WITH_O) {
#pragma unroll
            for (int r = 0; r < 16; ++r) { o[0][r] *= al; o[1][r] *= al; } }
    }
    float rs0 = 0.f, rs1 = 0.f;
#pragma unroll
    for (int r = 0; r < 16; ++r) { p0[r] = __builtin_amdgcn_exp2f(p0[r]); p1[r] = __builtin_amdgcn_exp2f(p1[r]); rs0 += p0[r]; rs1 += p1[r]; }
    lsum += on ? (rs0 + rs1) : 0.f;
}
DI void mask_tri(f32x16& p0, f32x16& p1, int kind, int tql, int hi) {
#pragma unroll
    for (int r = 0; r < 16; ++r) { const int k0 = crow(r, hi), k1 = 32 + k0;
        const bool m0 = kind == 1 ? (k0 > tql) : (k0 <= tql), m1 = kind == 1 ? (k1 > tql) : (k1 <= tql);
        if (m0) p0[r] = -INFINITY; if (m1) p1[r] = -INFINITY; }
}
DI void mix_acc(bf16_t* mix, const f32x16 (&o)[2], float sc, int hi, bool add) {
#pragma unroll
    for (int db = 0; db < 2; ++db)
#pragma unroll
        for (int a4 = 0; a4 < 4; ++a4) { u32x2* mp = (u32x2*)(mix + 32 * db + 8 * a4 + 4 * hi); float v[4];
#pragma unroll
            for (int e = 0; e < 4; ++e) v[e] = o[db][4 * a4 + e] * sc;
            if (add) { const u32x2 old = *mp; v[0] += bflo(old.x); v[1] += bfhi(old.x); v[2] += bflo(old.y); v[3] += bfhi(old.y); }
            u32x2 wv; wv.x = pk2(v[0], v[1]); wv.y = pk2(v[2], v[3]); *mp = wv; }
}
#define tile_gload(...) tile_gload_(tid, __VA_ARGS__)
#define tile_sts(...) tile_sts_(tid, __VA_ARGS__)
#define ATTN_PROLOGUE \
    const int tid = otid(), lane = tid & 63, w = tid >> 6, r32 = lane & 31, hi = lane >> 5; \
    const int hq = w >> 1, tql = (w & 1) * 32 + r32, T0 = b * SEQ + qb * 64, head = g * 4 + hq; \
    const bf16_t* Z = (const bf16_t*)(p.ws + WS_Z); \
    bf16_t* Ks = (bf16_t*)lds; bf16_t* Vt = (bf16_t*)(lds + 18432); float* imp = (float*)(lds + 36864); unsigned long long* selm = (unsigned long long*)(lds + 103424); \
    const bf16_t* zrow = Z + (size_t)(T0 + tql) * NZ; \
    bf16_t* mix = (bf16_t*)(p.ws + WS_MIX) + (size_t)(T0 + tql) * DM + head * 64; \
    (void)Ks; (void)Vt; (void)imp; (void)selm; (void)mix; (void)zrow; (void)lane;
#define ATTN_Q bf16x8 qr[4]; _Pragma("unroll") for (int d0 = 0; d0 < 4; ++d0) qr[d0] = *(const bf16x8*)(zrow + ZQ + head * 64 + d0 * 16 + hi * 8); \
    f32x16 o[2]; f32x16 p0, p1, negm; float m, lsum;
DI void attn_win(const Params& p, unsigned char* lds, int b, int g, int qb) {
    ATTN_PROLOGUE ATTN_Q
    {
        const bf16_t* kb = Z + (size_t)(b * SEQ) * NZ + ZKW + g * 64; const bf16_t* vb = Z + (size_t)(b * SEQ) * NZ + ZVW + g * 64;
        const int jlo = qb >= 8 ? qb - 8 : 0; int buf = 0;
        o[0] = (f32x16){}; o[1] = (f32x16){}; negm = (f32x16){}; m = 0.f; lsum = 0.f;
        TileRegs tr = tile_gload(kb + (size_t)qb * 64 * NZ, vb + (size_t)qb * 64 * NZ, NZ), tr2 = tr;
        tile_sts(tr, Ks, Vt);
        if (qb > jlo) tr = tile_gload(kb + (size_t)(qb - 1) * 64 * NZ, vb + (size_t)(qb - 1) * 64 * NZ, NZ);
        __syncthreads();
        for (int j = qb; j >= jlo; --j) {
            if (j > jlo + 1) tr2 = tile_gload(kb + (size_t)(j - 2) * 64 * NZ, vb + (size_t)(j - 2) * 64 * NZ, NZ);
            attn_S(Ks + buf * 4608, qr, negm, p0, p1, r32, hi);
            if (j == qb) mask_tri(p0, p1, 1, tql, hi); else if (j == qb - 8) mask_tri(p0, p1, 2, tql, hi);
            attn_softmax<true>(p0, p1, m, lsum, o, negm, true);
            attn_PV(Vt + buf * 4352, p0, p1, o, r32, hi, 0xffffffffu);
            if (j > jlo) tile_sts(tr, Ks + (buf ^ 1) * 4608, Vt + (buf ^ 1) * 4352);
            __syncthreads(); buf ^= 1; tr = tr2;
        }
        lsum += __shfl_xor(lsum, 32);
        const float g_w = bf2f(zrow[ZGT + head * 3 + 2]); const float sc = lsum > 0.f ? g_w / lsum : 0.f;
        mix_acc(mix, o, sc, hi, false);
    }
}
DI void attn_cmp(const Params& p, unsigned char* lds, int b, int g, int qb) {
    ATTN_PROLOGUE ATTN_Q
    float* invl = (float*)(lds + 104448);
    const bf16_t* kc = (const bf16_t*)(p.ws + WS_KC) + (size_t)(b * 2 + g) * 256 * 64; const bf16_t* vc = (const bf16_t*)(p.ws + WS_VC) + (size_t)(b * 2 + g) * 256 * 64;
    const int ncmp = 4 * qb + 3, ntc = (ncmp + 63) >> 6; const int t = qb * 64 + tql;
    m = 0.f; lsum = 0.f; negm = (f32x16){}; o[0] = (f32x16){}; o[1] = (f32x16){};
    float carry = 0.f; int buf = 0;
    TileRegs tr = tile_gload(kc, vc, 64), tr2 = tr; tile_sts(tr, Ks, Vt);
    if (ntc > 1) tr = tile_gload(kc + (size_t)64 * 64, vc + (size_t)64 * 64, 64);
    __syncthreads();
    for (int jc = 0; jc < ntc; ++jc) {
        if (jc + 2 < ntc) tr2 = tile_gload(kc + (size_t)(jc + 2) * 64 * 64, vc + (size_t)(jc + 2) * 64 * 64, 64);
        attn_S(Ks + buf * 4608, qr, negm, p0, p1, r32, hi);
#pragma unroll
        for (int r = 0; r < 16; ++r) { const int c0 = 64 * jc + crow(r, hi), c1 = c0 + 32; if (16 * c0 + 31 > t) p0[r] = -INFINITY; if (16 * c1 + 31 > t) p1[r] = -INFINITY; }
        const float m_old = m;
        attn_softmax<true>(p0, p1, m, lsum, o, negm, true);
        if (__any(m != m_old)) {
            const float al = __builtin_amdgcn_exp2f(m_old - m); carry *= al;
            for (int nn = hi; nn < 16 * jc; nn += 2) imp[(hq * 64 + tql) * 65 + nn] *= al; }
        attn_PV(Vt + buf * 4352, p0, p1, o, r32, hi, 0xffffffffu);
#pragma unroll
        for (int hf = 0; hf < 2; ++hf) {
            float mainv[4], oth[4];
#pragma unroll
            for (int a4 = 0; a4 < 4; ++a4) { const float q0 = hf ? p1[4 * a4] : p0[4 * a4], q1 = hf ? p1[4 * a4 + 1] : p0[4 * a4 + 1], q2 = hf ? p1[4 * a4 + 2] : p0[4 * a4 + 2], q3 = hf ? p1[4 * a4 + 3] : p0[4 * a4 + 3];
                const float sp = 0.5f * q3; mainv[a4] = (q0 + q1) + (q2 + sp); oth[a4] = __shfl_xor(sp, 32); }
#pragma unroll
            for (int a4 = 0; a4 < 4; ++a4) { const float add = hi ? oth[a4] : (a4 == 0 ? carry : oth[a4 - 1]);
                imp[(hq * 64 + tql) * 65 + 16 * jc + 8 * hf + 2 * a4 + hi] = mainv[a4] + add; }
            carry = oth[3];
        }
        if (jc + 1 < ntc) tile_sts(tr, Ks + (buf ^ 1) * 4608, Vt + (buf ^ 1) * 4352);
        __syncthreads(); buf ^= 1; tr = tr2;
    }
    lsum += __shfl_xor(lsum, 32);
    const float inv_l = lsum > 0.f ? 1.0f / lsum : 0.f;
    if (hi == 0) invl[hq * 64 + tql] = inv_l;
    const float g_c = bf2f(zrow[ZGT + head * 3 + 0]); mix_acc(mix, o, g_c * inv_l, hi, false);
    __syncthreads();
}
DI void attn_topk(const Params& p, unsigned char* lds, int b, int g, int qb, int sel_off) {
    ATTN_PROLOGUE
    {
        const int n = lane; const bool valid = n <= qb, forced = (n == 0) | (n == qb) | (n == qb - 1), cand = valid && !forced;
        unsigned kb[8];
#pragma unroll
        for (int tt = 0; tt < 8; ++tt) { const int tok = w * 8 + tt;
            const float* il = (const float*)(lds + 104448) + tok;
            const float sc = ((imp[(0 * 64 + tok) * 65 + n] * il[0] + imp[(1 * 64 + tok) * 65 + n] * il[64]) + imp[(2 * 64 + tok) * 65 + n] * il[128]) + imp[(3 * 64 + tok) * 65 + n] * il[192];
            kb[tt] = cand ? (__float_as_uint(sc) + 1u) : 0u; }
        if (qb >= 16) {
            unsigned T[8] = {0u, 0u, 0u, 0u, 0u, 0u, 0u, 0u};
            for (int bit = 30; bit >= 0; --bit) {
#pragma unroll
                for (int tt = 0; tt < 8; ++tt) { const unsigned c2 = T[tt] | (1u << bit); if (__popcll(__ballot(kb[tt] >= c2)) >= 13) T[tt] = c2; }
            }
#pragma unroll
            for (int tt = 0; tt < 8; ++tt) { const unsigned long long gtm = __ballot(kb[tt] > T[tt]), eqm = __ballot(kb[tt] == T[tt]);
                const int need = 13 - __popcll(gtm), rk = __popcll(eqm & ((1ull << n) - 1ull));
                const bool sel = forced || (cand && (kb[tt] > T[tt] || (kb[tt] == T[tt] && rk < need)));
                const unsigned long long mask = __ballot(sel);
                if (lane == 0) selm[sel_off + w * 8 + tt] = mask; }
        } else {
            const unsigned long long mask = __ballot(valid);
            if (lane < 8) selm[sel_off + w * 8 + lane] = mask;
        }
        __syncthreads();
    }
}
DI void attn_sel(const Params& p, unsigned char* lds, int b, int g, int qb) {
    ATTN_PROLOGUE ATTN_Q
    {
        unsigned long long bm = selm[lane];
#pragma unroll
        for (int o_ = 1; o_ < 64; o_ <<= 1) { const unsigned lo = __shfl_xor((unsigned)bm, o_), hh = __shfl_xor((unsigned)(bm >> 32), o_); bm |= ((unsigned long long)hh << 32) | lo; }
        const unsigned bmlo = __builtin_amdgcn_readfirstlane((unsigned)bm), bmhi = __builtin_amdgcn_readfirstlane((unsigned)(bm >> 32));
        unsigned long long rem = (((unsigned long long)bmhi << 32) | bmlo) | 1ull;
        const unsigned long long mysel = selm[tql];
        const bf16_t* kb = Z + (size_t)(b * SEQ) * NZ + ZKS + g * 64; const bf16_t* vb = Z + (size_t)(b * SEQ) * NZ + ZVS + g * 64;
        o[0] = (f32x16){}; o[1] = (f32x16){}; negm = (f32x16){}; m = 0.f; lsum = 0.f; int buf = 0;
        int j = __builtin_ctzll(rem); rem &= rem - 1;
        int jn = rem ? __builtin_ctzll(rem) : -1; rem &= rem - 1;
        TileRegs tr = tile_gload(kb + (size_t)j * 64 * NZ, vb + (size_t)j * 64 * NZ, NZ), tr2 = tr; tile_sts(tr, Ks, Vt);
        if (jn >= 0) tr = tile_gload(kb + (size_t)jn * 64 * NZ, vb + (size_t)jn * 64 * NZ, NZ);
        __syncthreads();
        for (;;) {
            const int jnn = rem ? __builtin_ctzll(rem) : -1; rem &= rem - 1;
            if (jnn >= 0) tr2 = tile_gload(kb + (size_t)jnn * 64 * NZ, vb + (size_t)jnn * 64 * NZ, NZ);
            attn_S(Ks + buf * 4608, qr, negm, p0, p1, r32, hi);
            if (j == qb) mask_tri(p0, p1, 1, tql, hi);
            const bool on = (mysel >> j) & 1ull;
            attn_softmax<true>(p0, p1, m, lsum, o, negm, on);
            attn_PV(Vt + buf * 4352, p0, p1, o, r32, hi, on ? 0xffffffffu : 0u);
            if (jn >= 0) tile_sts(tr, Ks + (buf ^ 1) * 4608, Vt + (buf ^ 1) * 4352);
            __syncthreads(); buf ^= 1;
            if (jn < 0) break; j = jn; jn = jnn; tr = tr2;
        }
        lsum += __shfl_xor(lsum, 32);
        const float g_s = bf2f(zrow[ZGT + head * 3 + 1]); const float sc = lsum > 0.f ? g_s / lsum : 0.f;
        mix_acc(mix, o, sc, hi, true);
    }
}


DI void softmax_pack(f32x16& p0, f32x16& p1, float& m, float& lsum, f32x16 (&o)[2], bool& shifted, bool on, u32x4 (&pw)[4]) {
    if (shifted) {
#pragma unroll
        for (int r = 0; r < 16; ++r) { p0[r] -= m; p1[r] -= m; } }
    float mx = rowmax32(p0, p1);
    if (!on) mx = -INFINITY;
    if (__any(mx > 8.0f)) {
        shifted = true;
        const float dl = fmaxf(mx, 0.f), al = __builtin_amdgcn_exp2f(-dl);
        m += dl; lsum *= al;
#pragma unroll
        for (int r = 0; r < 16; ++r) { p0[r] -= dl; p1[r] -= dl; o[0][r] *= al; o[1][r] *= al; }
    }
    float rs0 = 0.f, rs1 = 0.f;
#pragma unroll
    for (int r = 0; r < 16; ++r) { p0[r] = __builtin_amdgcn_exp2f(p0[r]); p1[r] = __builtin_amdgcn_exp2f(p1[r]); rs0 += p0[r]; rs1 += p1[r]; }
    lsum += on ? (rs0 + rs1) : 0.f;
    const unsigned lmask = on ? 0xffffffffu : 0u;
#pragma unroll
    for (int s = 0; s < 2; ++s)
#pragma unroll
        for (int e = 0; e < 4; ++e) { pw[s][e] = pk2(p0[8 * s + 2 * e], p0[8 * s + 2 * e + 1]) & lmask; pw[2 + s][e] = pk2(p1[8 * s + 2 * e], p1[8 * s + 2 * e + 1]) & lmask; }
}
DI void S_pair(const bf16_t* Kb, const bf16x8 (&qa)[4], const bf16x8* qbl, f32x16& a0, f32x16& a1, f32x16& b0, f32x16& b1, int r32, int hi) {
    { const bf16x8 k0 = *(const bf16x8*)(Kb + r32 * 72 + hi * 8), k1 = *(const bf16x8*)(Kb + (32 + r32) * 72 + hi * 8); const bf16x8 qv = qbl[0];
      a0 = MFMA32(k0, qa[0], (f32x16){}); a1 = MFMA32(k1, qa[0], (f32x16){}); b0 = MFMA32(k0, qv, (f32x16){}); b1 = MFMA32(k1, qv, (f32x16){}); }
#pragma unroll
    for (int d0 = 1; d0 < 4; ++d0) { const bf16x8 k0 = *(const bf16x8*)(Kb + r32 * 72 + d0 * 16 + hi * 8), k1 = *(const bf16x8*)(Kb + (32 + r32) * 72 + d0 * 16 + hi * 8); const bf16x8 qv = qbl[d0 * 512];
        a0 = MFMA32(k0, qa[d0], a0); a1 = MFMA32(k1, qa[d0], a1); b0 = MFMA32(k0, qv, b0); b1 = MFMA32(k1, qv, b1); }
}
DI void PV_pair(const bf16_t* Vb, const u32x4 (&pwa)[4], const u32x4 (&pwb)[4], f32x16 (&oa)[2], f32x16 (&ob)[2], int r32, int hi) {
#pragma unroll
    for (int hs = 0; hs < 4; ++hs) { const int hf = hs >> 1, s = hs & 1;
        const bf16x8 pa = __builtin_bit_cast(bf16x8, pwa[hs]), pb = __builtin_bit_cast(bf16x8, pwb[hs]);
#pragma unroll
        for (int db = 0; db < 2; ++db) { const bf16_t* vp = Vb + (r32 + 32 * db) * 68 + 32 * hf + 16 * s + 4 * hi;
            const s16x4 lo = *(const s16x4*)vp, hh = *(const s16x4*)(vp + 8);
            const bf16x8 va = __builtin_shufflevector(lo, hh, 0, 1, 2, 3, 4, 5, 6, 7);
            oa[db] = MFMA32(va, pa, oa[db]);
            ob[db] = MFMA32(va, pb, ob[db]); }
        __builtin_amdgcn_sched_barrier(0);
    }
}
#define PAIR_PROLOGUE \
    const int tid = otid(), lane = tid & 63, w = tid >> 6, r32 = lane & 31, hi = lane >> 5; \
    const int hq = w >> 1, tql = (w & 1) * 32 + r32, head = g * 4 + hq, qb1 = qb0 + 1; \
    const bf16_t* Z = (const bf16_t*)(p.ws + WS_Z); \
    bf16_t* Ks = (bf16_t*)lds; bf16_t* Vt = (bf16_t*)(lds + 18432); unsigned long long* selm = (unsigned long long*)(lds + 103424); (void)selm; \
    const bf16_t* zrA = Z + (size_t)(b * SEQ + qb0 * 64 + tql) * NZ; const bf16_t* zrB = zrA + (size_t)64 * NZ; \
    bf16_t* mixA = (bf16_t*)(p.ws + WS_MIX) + (size_t)(b * SEQ + qb0 * 64 + tql) * DM + head * 64; bf16_t* mixB = mixA + (size_t)64 * DM; \
    bf16x8 qA[4]; bf16x8* qBl = (bf16x8*)(lds + 104448) + tid; _Pragma("unroll") for (int d0 = 0; d0 < 4; ++d0) { qA[d0] = *(const bf16x8*)(zrA + ZQ + head * 64 + d0 * 16 + hi * 8); qBl[d0 * 512] = *(const bf16x8*)(zrB + ZQ + head * 64 + d0 * 16 + hi * 8); } \
    f32x16 oA[2] = {(f32x16){}, (f32x16){}}, oB[2] = {(f32x16){}, (f32x16){}}; f32x16 pa0, pa1, pb0, pb1; float mA = 0.f, mB = 0.f, lA = 0.f, lB = 0.f; bool shA = false, shB = false; \
    u32x4 pwA[4], pwB[4];
DI void attn_win2(const Params& p, unsigned char* lds, int b, int g, int qb0) {
    PAIR_PROLOGUE
    const bf16_t* kb = Z + (size_t)(b * SEQ) * NZ + ZKW + g * 64; const bf16_t* vb = Z + (size_t)(b * SEQ) * NZ + ZVW + g * 64;
    const int jlo = qb0 >= 8 ? qb0 - 8 : 0; int buf = 0;
    { TileRegs tr = tile_gload(kb + (size_t)qb1 * 64 * NZ, vb + (size_t)qb1 * 64 * NZ, NZ); tile_sts(tr, Ks, Vt); }
    __syncthreads();
    for (int j = qb1; j >= jlo; --j) {
        TileRegs tr; if (j > jlo) tr = tile_gload(kb + (size_t)(j - 1) * 64 * NZ, vb + (size_t)(j - 1) * 64 * NZ, NZ);
        const bool ra = (j <= qb0) && (j >= qb0 - 8), rb = (j >= qb1 - 8);
        S_pair(Ks + buf * 4608, qA, qBl, pa0, pa1, pb0, pb1, r32, hi);
        if (j == qb0) mask_tri(pa0, pa1, 1, tql, hi); else if (j == qb0 - 8) mask_tri(pa0, pa1, 2, tql, hi);
        softmax_pack(pa0, pa1, mA, lA, oA, shA, ra, pwA);
        if (j == qb1) mask_tri(pb0, pb1, 1, tql, hi); else if (j == qb1 - 8) mask_tri(pb0, pb1, 2, tql, hi);
        softmax_pack(pb0, pb1, mB, lB, oB, shB, rb, pwB);
        PV_pair(Vt + buf * 4352, pwA, pwB, oA, oB, r32, hi);
        if (j > jlo) tile_sts(tr, Ks + (buf ^ 1) * 4608, Vt + (buf ^ 1) * 4352);
        __syncthreads(); buf ^= 1;
    }
    lA += __shfl_xor(lA, 32); lB += __shfl_xor(lB, 32);
    const float gA = bf2f(zrA[ZGT + head * 3 + 2]), gB = bf2f(zrB[ZGT + head * 3 + 2]);
    mix_acc(mixA, oA, lA > 0.f ? gA / lA : 0.f, hi, true); mix_acc(mixB, oB, lB > 0.f ? gB / lB : 0.f, hi, true);
}
DI void attn_sel2(const Params& p, unsigned char* lds, int b, int g, int qb0) {
    PAIR_PROLOGUE
    unsigned long long bm = selm[lane] | selm[64 + lane];
#pragma unroll
    for (int o_ = 1; o_ < 64; o_ <<= 1) { const unsigned lo = __shfl_xor((unsigned)bm, o_), hh = __shfl_xor((unsigned)(bm >> 32), o_); bm |= ((unsigned long long)hh << 32) | lo; }
    const unsigned bmlo = __builtin_amdgcn_readfirstlane((unsigned)bm), bmhi = __builtin_amdgcn_readfirstlane((unsigned)(bm >> 32));
    unsigned long long rem = (((unsigned long long)bmhi << 32) | bmlo) | 1ull;
    const unsigned long long selA = selm[tql], selB = selm[64 + tql];
    const bf16_t* kb = Z + (size_t)(b * SEQ) * NZ + ZKS + g * 64; const bf16_t* vb = Z + (size_t)(b * SEQ) * NZ + ZVS + g * 64;
    int buf = 0;
    int j = __builtin_ctzll(rem); rem &= rem - 1;
    { TileRegs tr = tile_gload(kb + (size_t)j * 64 * NZ, vb + (size_t)j * 64 * NZ, NZ); tile_sts(tr, Ks, Vt); }
    __syncthreads();
    for (;;) {
        const int jn = rem ? __builtin_ctzll(rem) : -1; rem &= rem - 1;
        TileRegs tr; if (jn >= 0) tr = tile_gload(kb + (size_t)jn * 64 * NZ, vb + (size_t)jn * 64 * NZ, NZ);
        const bool ra = j <= qb0;
        S_pair(Ks + buf * 4608, qA, qBl, pa0, pa1, pb0, pb1, r32, hi);
        if (j == qb0) mask_tri(pa0, pa1, 1, tql, hi);
        softmax_pack(pa0, pa1, mA, lA, oA, shA, ra && ((selA >> j) & 1ull), pwA);
        if (j == qb1) mask_tri(pb0, pb1, 1, tql, hi);
        softmax_pack(pb0, pb1, mB, lB, oB, shB, (selB >> j) & 1ull, pwB);
        PV_pair(Vt + buf * 4352, pwA, pwB, oA, oB, r32, hi);
        if (jn >= 0) tile_sts(tr, Ks + (buf ^ 1) * 4608, Vt + (buf ^ 1) * 4352);
        __syncthreads(); buf ^= 1;
        if (jn < 0) break; j = jn;
    }
    lA += __shfl_xor(lA, 32); lB += __shfl_xor(lB, 32);
    const float gA = bf2f(zrA[ZGT + head * 3 + 1]), gB = bf2f(zrB[ZGT + head * 3 + 1]);
    mix_acc(mixA, oA, lA > 0.f ? gA / lA : 0.f, hi, true); mix_acc(mixB, oB, lB > 0.f ? gB / lB : 0.f, hi, true);
}
DI void attn_pair(const Params& p, unsigned char* lds, int b, int g, int qp) {
    const int qb0 = 2 * qp;
    attn_cmp(p, lds, b, g, qb0); attn_topk(p, lds, b, g, qb0, 0);
    attn_cmp(p, lds, b, g, qb0 + 1); attn_topk(p, lds, b, g, qb0 + 1, 64);
    attn_win2(p, lds, b, g, qb0);
    attn_sel2(p, lds, b, g, qb0);
}

#define XB_TMO      128
#define XB_XCNT(j)  (256  + 64 * (j))
#define XB_XSUB(j)  (1280 + 64 * (j))
#define XB_XGEN(j)  (2304 + 64 * (j))
#define XB_TOP      3328
#define XB_TOPGEN   3392
#define XCD_BAR_WORDS 3456
#define XB_SPIN_CAP (1u << 22)
DI unsigned xb_ld(unsigned* p)              { return __hip_atomic_load(p, __ATOMIC_RELAXED, __HIP_MEMORY_SCOPE_AGENT); }
DI unsigned xb_add(unsigned* p, unsigned v) { return __hip_atomic_fetch_add(p, v, __ATOMIC_RELAXED, __HIP_MEMORY_SCOPE_AGENT); }
DI unsigned xb_xcc_id() { return (unsigned)__builtin_amdgcn_s_getreg((3 << 11) | 20) & 0xFu; }
#define XB_SPIN(cond, bar) do { unsigned _sp = 0; while (cond) { __builtin_amdgcn_s_sleep(1); \
    if ((++_sp & 255u) == 0u) { if (xb_ld(&(bar)[XB_TMO])) break; if (_sp > XB_SPIN_CAP) { atomicAdd(&(bar)[XB_TMO], 1u); break; } } } } while (0)
struct XcdBarrier { unsigned* bar; unsigned x; volatile LAS unsigned* st; };
DI XcdBarrier xcd_barrier_post(unsigned* bar, volatile LAS unsigned* st) {
    XcdBarrier b; b.bar = bar; b.x = xb_xcc_id(); b.st = st;
    if (threadIdx.x == 0) (void)xb_add(&bar[XB_XCNT(b.x)], 1u);
    return b;
}
DI void xcd_barrier_complete(unsigned* bar, unsigned x, unsigned& nloc, unsigned& nx) {
    const unsigned G = gridDim.x * gridDim.y * gridDim.z;
    unsigned sum, cnt, mine, sp = 0u;
    for (;;) {
        sum = 0u; cnt = 0u; mine = 0u;
#pragma unroll
        for (unsigned j = 0; j < 16; ++j) { const unsigned c = xb_ld(&bar[XB_XCNT(j)]); sum += c; cnt += (c > 0u) ? 1u : 0u; mine = (j == x) ? c : mine; }
        if (sum == G) break;
        __builtin_amdgcn_s_sleep(1);
        if ((++sp & 255u) == 0u) { if (xb_ld(&bar[XB_TMO])) break; if (sp > XB_SPIN_CAP) { atomicAdd(&bar[XB_TMO], 1u); break; } }
    }
    nloc = mine > 0u ? mine : 1u; nx = cnt > 0u ? cnt : 1u;
}
DI void xcd_barrier(const XcdBarrier& b) {
    asm volatile("s_waitcnt vmcnt(0)" ::: "memory");
    __syncthreads();
    if (threadIdx.x == 0) {
        unsigned* bar = b.bar;
        __builtin_amdgcn_s_waitcnt(0);
        unsigned nloc = b.st[0], nx = b.st[1];
        if (nloc == 0u) { xcd_barrier_complete(bar, b.x, nloc, nx); b.st[0] = nloc; b.st[1] = nx; }
        const unsigned old = xb_add(&bar[XB_XSUB(b.x)], 1u);
        const unsigned gen = old / nloc;
        if (old + 1u == (gen + 1u) * nloc) {
            __builtin_amdgcn_fence(__ATOMIC_RELEASE, "agent");
            asm volatile("s_waitcnt vmcnt(0)" ::: "memory");
            const unsigned og = xb_add(&bar[XB_TOP], 1u);
            const unsigned tg = og / nx;
            if (og + 1u == (tg + 1u) * nx) xb_add(&bar[XB_TOPGEN], 1u);
            else XB_SPIN(xb_ld(&bar[XB_TOPGEN]) == tg, bar);
            __builtin_amdgcn_fence(__ATOMIC_ACQUIRE, "agent");
            xb_add(&bar[XB_XGEN(b.x)], 1u);
            asm volatile("s_waitcnt vmcnt(0)" ::: "memory");
        } else {
            XB_SPIN(xb_ld(&bar[XB_XGEN(b.x)]) == gen, bar);
            __builtin_amdgcn_fence(__ATOMIC_ACQUIRE, "agent");
            asm volatile("s_waitcnt vmcnt(0)" ::: "memory");
        }
    }
    __syncthreads();
}

#ifndef PH_MASK
#define PH_MASK 0xFFFF
#endif
#define PH(b) ((PH_MASK >> (b)) & 1)
#ifndef DUP_MASK
#define DUP_MASK 0
#endif
#define REP(b) for (int rep_ = 0; rep_ < 1 + ((DUP_MASK >> (b)) & 1); ++rep_)
__global__ void __launch_bounds__(512, 2) hybrid_fwd(Params p) {
    extern __shared__ __attribute__((aligned(16))) unsigned char lds[];
    cg::grid_group grid_ = cg::this_grid();
    LAS unsigned char* ldsl = (LAS unsigned char*)lds;
    unsigned char* ws = p.ws;
    const int G = gridDim.x, bx = blockIdx.x, tid = threadIdx.x;
    bf16_t* Zb = (bf16_t*)(ws + WS_Z); bf16_t* XB = (bf16_t*)(ws + WS_XB); bf16_t* MIX = (bf16_t*)(ws + WS_MIX); bf16_t* HF = Zb;
    bf16_t* XLp = (bf16_t*)(ws + WS_XL);
    float* ssqA = (float*)(ws + WS_SSQA); float* ssqB = (float*)(ws + WS_SSQB);

    volatile LAS unsigned* MISC = (volatile LAS unsigned*)(ldsl + LDS_MISC);
    if (tid < 64) MISC[tid] = 0u;
    if (bx == 0) for (int i = tid; i < 16384; i += 512) ((unsigned*)(ws + WS_CTL))[i] = 0u;
    __syncthreads();
    REP(0) if (PH(0)) phase0(p, lds);
    grid_.sync();
    const XcdBarrier xbar = xcd_barrier_post((unsigned*)(ws + WS_CTL), MISC + 8);
    struct GS { const XcdBarrier& b; DI void sync() const { xcd_barrier(b); } } grid{xbar};
    for (int l = 0; l < NL; ++l) {
        REP(1) if (PH(1)) { pg8::Gemm g{XB, (const bf16_t*)(ws + WS_WIN) + (size_t)l * NZ * WP, DM, DM * 2, 128, WP * 2}; pg8::StaticOrder S; S.init(MTOK, NZ, G, bx);
          EpiIn E{Zb, ssqA, (const float*)(ws + WS_ROPE)}; pg8::gemm_phase(ldsl, g, S, E); }
        grid.sync();
        REP(2) if (!PH(2)) {} else if (bx < 32) {
            const int set = bx >> 3, kv = set >> 1, gg = set & 1;
            pg8::Gemm g{Zb + (kv ? ZVC : ZKC) + gg * 64, (const bf16_t*)(ws + WS_WC1) + (size_t)(l * 2 + kv) * 256 * WPC, 2048, 16u * NZ * 2u, (unsigned)NZ * 2u, WPC * 2};
            pg8::OneUnit S{bx & 7}; EpiCmp E{(bf16_t*)(ws + WS_CH) + (size_t)set * 2048 * 256, (const float*)(ws + WS_POSB) + (l * 2 + kv) * 256};
            pg8::gemm_phase(ldsl, g, S, E);
        } else {
            REP(3) if (PH(3)) { sg_item(p, l, bx - 32, lds); if (bx >= G - 32) sg_item(p, l, bx - 32 + 32, lds); }
            REP(4) if (PH(4)) for (int it = 2 * (bx - 32); it < 2048; it += 2 * (G - 32)) gla_g1_pair(p, l, it, 2048, lds);
        }
        grid.sync();
        { const int t2 = otid(); if (PH(5) && bx < 128) gla_g2(p, bx * 512 + t2); else if (bx < 160) compress2(p, l, (bx - 128) >> 3, (bx - 128) & 7); }
        grid.sync();
        { const int xcd = bx & 7, cu = bx >> 3; const int bg = xcd * 2 + (cu >> 4), s = cu & 15;
          REP(6) if (PH(6)) for (int i = 0; i < 2; ++i) { const int qp = i ? s : 31 - s; attn_pair(p, lds, bg >> 1, bg & 1, qp); __syncthreads(); }
          REP(7) if (PH(7)) { const int t3 = otid(); int it = bx; G3Regs cur = gla_g3_load(p, it, t3);
              for (;;) { const int nx = it + G; G3Regs nxt = cur; if (nx < 2048) nxt = gla_g3_load(p, nx, t3);
                  gla_g3(p, l, it, lds, t3, cur); if (nx >= 2048) break; cur = nxt; it = nx; } } }
        grid.sync();
        if (PH(8)) { pg8::Gemm g{MIX, (const bf16_t*)(ws + WS_WOUT) + (size_t)l * DM * WP, DM, DM * 2, 128, WP * 2}; pg8::StaticOrder S; S.init(MTOK, DM, G, bx);
          EpiRes E{XB, XLp, ssqB}; pg8::gemm_phase(ldsl, g, S, E); }
        grid.sync();
        REP(9) if (PH(9)) { pg8::Gemm g{XB, (const bf16_t*)(ws + WS_WGU) + (size_t)l * 2 * DFF * WP, DM, DM * 2, 128, WP * 2}; pg8::StaticOrder S; S.init(MTOK, 2 * DFF, G, bx);
          EpiGlu E{HF, ssqB}; pg8::gemm_phase(ldsl, g, S, E); }
        grid.sync();
        if (PH(10)) { pg8::Gemm g{HF, (const bf16_t*)(ws + WS_WDN) + (size_t)l * DM * DFF, DFF, DFF * 2, 128, 0}; pg8::StaticOrder S; S.init(MTOK, DM, G, bx);
          EpiRes E{XB, XLp, ssqA}; pg8::gemm_phase(ldsl, g, S, E); }
        grid.sync();
    }
    { const int lane = tid & 63, gw = bx * 8 + (tid >> 6), NGW = G * 8; const float* fg = p.in[21];
      for (int mrow = gw; mrow < MTOK; mrow += NGW) { const u32x2* hr = (const u32x2*)(XB + (size_t)mrow * DM) + lane; const u32x2* lr = (const u32x2*)(XLp + (size_t)mrow * DM) + lane; f32x4* xo = (f32x4*)(p.out + (size_t)mrow * DM) + lane; f32x4 v[4]; float s = 0.f;
#pragma unroll
          for (int j = 0; j < 4; ++j) { const u32x2 h = hr[64 * j], lw = lr[64 * j]; v[j] = (f32x4){bflo(h.x) + bflo(lw.x), bfhi(h.x) + bfhi(lw.x), bflo(h.y) + bflo(lw.y), bfhi(h.y) + bfhi(lw.y)}; s += (v[j].x * v[j].x + v[j].y * v[j].y) + (v[j].z * v[j].z + v[j].w * v[j].w); }
          const float rinv = rsqrtf(wave_sum(s) * (1.0f / DM) + EPS);
#pragma unroll
          for (int j = 0; j < 4; ++j) { const f32x4 gv = *((const f32x4*)fg + lane + 64 * j); xo[64 * j] = v[j] * rinv * gv; } } }
}

extern "C" void kernel_launch(void* const* d_in, const int* in_sizes, int n_in, void* d_out, int out_size, void* d_ws, size_t ws_size, hipStream_t stream) {
    static int grid = 0;
    if (grid == 0) {
        if (n_in != 22 || out_size != MTOK * DM || ws_size < WS_END) { fprintf(stderr, "kernel_launch: unexpected shapes (n_in %d out %d ws %zu need %zu)\n", n_in, out_size, ws_size, (size_t)WS_END); grid = -1; return; }
        int dev = 0, cus = 0, per_cu = 0;
        hipGetDevice(&dev); hipDeviceGetAttribute(&cus, hipDeviceAttributeMultiprocessorCount, dev);
        hipFuncSetAttribute((const void*)hybrid_fwd, hipFuncAttributeMaxDynamicSharedMemorySize, LDS_BYTES);
        hipOccupancyMaxActiveBlocksPerMultiprocessor(&per_cu, (const void*)hybrid_fwd, 512, LDS_BYTES);
        if (per_cu < 1) { fprintf(stderr, "kernel_launch: occupancy query says %d blocks/CU\n", per_cu); per_cu = 1; }
        grid = cus;
        if (grid != 256) fprintf(stderr, "kernel_launch: note: %d CUs\n", grid);
    }
    if (grid < 0) return;
    Params p{};
    for (int i = 0; i < 22; ++i) p.in[i] = (const float*)d_in[i];
    p.out = (float*)d_out; p.ws = (unsigned char*)d_ws;
    void* args[] = {&p};
    hipError_t e = hipLaunchCooperativeKernel((const void*)hybrid_fwd, dim3(grid), dim3(512), args, LDS_BYTES, stream);
    if (e != hipSuccess) fprintf(stderr, "cooperative launch failed: %s (grid %d)\n", hipGetErrorString(e), grid);
}
```
